# Optimizing an MI355X kernel written in HIP

```python
import jax
import jax.numpy as jnp
from jax import lax
import numpy as np

D_MODEL = 1024
BATCH = 8
SEQ = 4096
DEPTH = 4

GRID_W = 64
HEAD_DIM = 64
RMS_EPS = 1e-6
NEG_INF = -1e30
Q_BLOCK = 128

A_HEADS = 4
NA_ROWS_MAX = 8
NA_COLS = 16
B_HEADS = 4
DILATED_BRANCHES = ((128, 1), (512, 4), (2048, 16))
C_HEADS = 8
C_KV_HEADS = 2
ROPE_THETA = 10000.0

A_W = A_HEADS * HEAD_DIM
B_W = B_HEADS * HEAD_DIM
C_W = C_HEADS * HEAD_DIM
C_KV_W = C_KV_HEADS * HEAD_DIM
MIX_W = A_W + B_W + C_W
IN_SPLITS = (A_W, A_W, A_W, B_W, B_W, B_W, C_W, C_KV_W, C_KV_W)
IN_COLS = sum(IN_SPLITS)

N_GROUPS = 4
EXPERTS_PER_GROUP = 8
N_EXPERTS = N_GROUPS * EXPERTS_PER_GROUP
TOP_K_IN_GROUP = 2
D_EXPERT = 512
MOE_BLOCK = 256

kernel_name = "hybrid_na_dilated_gqa_hiermoe_encoder"


def rms_norm(x, g):
    xf = x.astype(jnp.float32)
    y = xf * lax.rsqrt(jnp.mean(xf * xf, axis=-1, keepdims=True) + RMS_EPS)
    return (y * g.astype(jnp.float32)).astype(x.dtype)


def alibi_slopes(n):
    return jnp.exp2(-8.0 * jnp.arange(1, n + 1, dtype=jnp.float32) / n)


def axial_rope(x):
    b, s, h, d = x.shape
    n_freq = d // 4
    t = jnp.arange(s)
    inv_freq = ROPE_THETA ** (-jnp.arange(n_freq, dtype=jnp.float32) / n_freq)
    rows = (t // GRID_W).astype(jnp.float32)
    cols = (t % GRID_W).astype(jnp.float32)
    ang = jnp.stack([rows[:, None] * inv_freq, cols[:, None] * inv_freq], axis=1)
    cos = jnp.cos(ang)[None, :, None]
    sin = jnp.sin(ang)[None, :, None]
    xr = x.astype(jnp.float32).reshape(b, s, h, 2, 2, n_freq)
    x1, x2 = xr[..., 0, :], xr[..., 1, :]
    out = jnp.stack([x1 * cos - x2 * sin, x2 * cos + x1 * sin], axis=-2)
    return out.reshape(b, s, h, d).astype(x.dtype)


def neighbourhood_attention(q, k, v, rpb):
    bsz, s, h, hd = q.shape
    rows = s // GRID_W
    kh = min(NA_ROWS_MAX, rows)
    scale = hd ** -0.5
    qg = q.reshape(bsz, rows, GRID_W, h, hd)
    kg = k.reshape(bsz, rows, GRID_W, h, hd)
    vg = v.reshape(bsz, rows, GRID_W, h, hd)
    cols = jnp.arange(GRID_W)
    col_start = jnp.clip(cols - NA_COLS // 2, 0, GRID_W - NA_COLS)
    col_idx = col_start[:, None] + jnp.arange(NA_COLS)[None, :]
    dc = col_idx - cols[:, None]

    def row_block(args):
        r, q_row = args
        r0 = jnp.clip(r - kh // 2, 0, rows - kh)
        k_rows = lax.dynamic_slice_in_dim(kg, r0, kh, axis=1)
        v_rows = lax.dynamic_slice_in_dim(vg, r0, kh, axis=1)
        k_nb = k_rows[:, :, col_idx]
        v_nb = v_rows[:, :, col_idx]
        sc = jnp.einsum('bqhd,bkqjhd->bhqkj', q_row, k_nb,
                        preferred_element_type=jnp.float32) * scale
        dr = r0 + jnp.arange(kh) - r
        bias = rpb[:, (dr + NA_ROWS_MAX - 1)[None, :, None], (dc + NA_COLS - 1)[:, None, :]]
        sc = sc + bias.astype(jnp.float32)[None]
        p = jax.nn.softmax(sc.reshape(bsz, h, GRID_W, kh * NA_COLS), axis=-1)
        p = p.reshape(bsz, h, GRID_W, kh, NA_COLS).astype(v.dtype)
        return jnp.einsum('bhqkj,bkqjhd->bqhd', p, v_nb)

    out = lax.map(row_block, (jnp.arange(rows), qg.transpose(1, 0, 2, 3, 4)))
    return out.transpose(1, 0, 2, 3, 4).reshape(bsz, s, h * hd)


def dilated_attention(q, k, v):
    bsz, s, h, hd = q.shape
    scale = hd ** -0.5
    slopes = alibi_slopes(h)
    n_blocks = s // Q_BLOCK
    qb = q.reshape(bsz, n_blocks, Q_BLOCK, h, hd).transpose(1, 0, 2, 3, 4)

    def block(args):
        i, q_blk = args
        pos = i * Q_BLOCK + jnp.arange(Q_BLOCK)
        maxes, dens, nums = [], [], []
        for window, dil in DILATED_BRANCHES:
            half = window // (2 * dil)
            offs = dil * jnp.arange(-half, half + 1)
            kp = pos[:, None] + offs[None, :]
            valid = (kp >= 0) & (kp < s)
            kpc = jnp.clip(kp, 0, s - 1)
            k_sel = jnp.take(k, kpc, axis=1)
            v_sel = jnp.take(v, kpc, axis=1)
            sc = jnp.einsum('bqhd,bqjhd->bhqj', q_blk, k_sel,
                            preferred_element_type=jnp.float32) * scale
            sc = sc - slopes[:, None, None] * jnp.abs(offs).astype(jnp.float32)[None, None, :]
            sc = jnp.where(valid[None, None], sc, NEG_INF)
            m = jnp.max(sc, axis=-1)
            p = jnp.exp(sc - m[..., None])
            maxes.append(m)
            dens.append(jnp.sum(p, axis=-1))
            nums.append(jnp.einsum('bhqj,bqjhd->bhqd', p, v_sel.astype(jnp.float32)))
        m_all = jnp.max(jnp.stack(maxes), axis=0)
        wts = [jnp.exp(m - m_all) for m in maxes]
        num = sum(w[..., None] * n for w, n in zip(wts, nums))
        den = sum(w * d for w, d in zip(wts, dens))
        o = num / den[..., None]
        return o.transpose(0, 2, 1, 3).astype(q.dtype)

    out = lax.map(block, (jnp.arange(n_blocks), qb))
    return out.transpose(1, 0, 2, 3, 4).reshape(bsz, s, h * hd)


def gqa_attention(q, k, v):
    bsz, s, hq, hd = q.shape
    hkv = k.shape[2]
    grp = hq // hkv
    scale = hd ** -0.5
    n_blocks = s // Q_BLOCK
    qb = q.reshape(bsz, n_blocks, Q_BLOCK, hkv, grp, hd).transpose(1, 0, 2, 3, 4, 5)

    def block(q_blk):
        sc = jnp.einsum('bqkgd,bskd->bkgqs', q_blk, k,
                        preferred_element_type=jnp.float32) * scale
        p = jax.nn.softmax(sc, axis=-1).astype(v.dtype)
        return jnp.einsum('bkgqs,bskd->bqkgd', p, v)

    out = lax.map(block, qb)
    return out.transpose(1, 0, 2, 3, 4, 5).reshape(bsz, s, hq * hd)


def mixer_sublayer(x, norm_g, w_in, qk_g, rpb, mix_g, w_out):
    bsz, s, _ = x.shape
    h = rms_norm(x, norm_g)
    proj = h @ w_in
    qa, ka, va, qb, kb, vb, qc, kc, vc = jnp.split(proj, list(np.cumsum(IN_SPLITS)[:-1]), axis=-1)

    def heads(t):
        return t.reshape(bsz, s, t.shape[-1] // HEAD_DIM, HEAD_DIM)

    qa = rms_norm(heads(qa), qk_g[0, 0])
    ka = rms_norm(heads(ka), qk_g[0, 1])
    qb = rms_norm(heads(qb), qk_g[1, 0])
    kb = rms_norm(heads(kb), qk_g[1, 1])
    qc = axial_rope(rms_norm(heads(qc), qk_g[2, 0]))
    kc = axial_rope(rms_norm(heads(kc), qk_g[2, 1]))

    oa = neighbourhood_attention(qa, ka, heads(va), rpb)
    ob = dilated_attention(qb, kb, heads(vb))
    oc = gqa_attention(qc, kc, heads(vc))

    merged = jnp.concatenate([
        rms_norm(oa, mix_g[:A_W]),
        rms_norm(ob, mix_g[A_W:A_W + B_W]),
        rms_norm(oc, mix_g[A_W + B_W:]),
    ], axis=-1)
    return merged @ w_out


def hier_moe(h, w_rg, b_rg, w_re, b_re, w_gate, w_up, w_down):
    bsz, s, d = h.shape
    n = bsz * s
    xt = h.reshape(n, d)
    g_logits = jnp.dot(xt, w_rg, preferred_element_type=jnp.float32) + b_rg.astype(jnp.float32)
    g_prob = jax.nn.softmax(g_logits, axis=-1)
    grp = jnp.argmax(g_logits, axis=-1)
    p_grp = jnp.take_along_axis(g_prob, grp[:, None], axis=1)[:, 0]
    e_logits = (jnp.dot(xt, w_re, preferred_element_type=jnp.float32)
                + b_re.astype(jnp.float32)).reshape(n, N_GROUPS, EXPERTS_PER_GROUP)
    e_in = jnp.take_along_axis(e_logits, grp[:, None, None], axis=1)[:, 0]
    top_v, top_i = lax.top_k(e_in, TOP_K_IN_GROUP)
    gate = p_grp[:, None] * jax.nn.softmax(top_v, axis=-1)

    eid = (grp[:, None] * EXPERTS_PER_GROUP + top_i).reshape(-1).astype(jnp.int32)
    tok = jnp.repeat(jnp.arange(n, dtype=jnp.int32), TOP_K_IN_GROUP)
    wgt = gate.reshape(-1).astype(h.dtype)
    n_pairs = n * TOP_K_IN_GROUP
    cap = n_pairs + N_EXPERTS * MOE_BLOCK
    n_blk = cap // MOE_BLOCK

    order = jnp.argsort(eid)
    e_sorted = eid[order]
    counts = jnp.bincount(eid, length=N_EXPERTS)
    starts = jnp.cumsum(counts) - counts
    padded = (counts + MOE_BLOCK - 1) // MOE_BLOCK * MOE_BLOCK
    p_ends = jnp.cumsum(padded)
    p_starts = p_ends - padded
    dest = p_starts[e_sorted] + jnp.arange(n_pairs, dtype=jnp.int32) - starts[e_sorted]
    slot_tok = jnp.zeros((cap,), jnp.int32).at[dest].set(tok[order])
    slot_w = jnp.zeros((cap,), h.dtype).at[dest].set(wgt[order])
    blk_e = jnp.minimum(
        jnp.searchsorted(p_ends, jnp.arange(n_blk, dtype=jnp.int32) * MOE_BLOCK, side='right'),
        N_EXPERTS - 1)

    def expert_block(args):
        e, idx = args
        xb = xt[idx]
        return (jax.nn.silu(xb @ w_gate[e]) * (xb @ w_up[e])) @ w_down[e]

    y = lax.map(expert_block, (blk_e, slot_tok.reshape(n_blk, MOE_BLOCK))).reshape(cap, d)
    out = jnp.zeros_like(xt).at[slot_tok].add(y * slot_w[:, None])
    return out.reshape(bsz, s, d)


def setup_inputs(seed: int = 0) -> dict:
    key = jax.random.key(seed)
    ks = jax.random.split(key, 16)
    f32 = jnp.float32
    nrm = jax.random.normal
    return {
        "x": nrm(ks[0], (BATCH, SEQ, D_MODEL), f32),
        "norm1_g": 1.0 + 0.05 * nrm(ks[1], (DEPTH, D_MODEL), f32),
        "w_in": nrm(ks[2], (DEPTH, D_MODEL, IN_COLS), f32) * D_MODEL ** -0.5,
        "qk_norm_g": 1.0 + 0.05 * nrm(ks[3], (DEPTH, 3, 2, HEAD_DIM), f32),
        "na_rpb": 0.1 * nrm(ks[4], (DEPTH, A_HEADS, 2 * NA_ROWS_MAX - 1, 2 * NA_COLS - 1), f32),
        "mix_norm_g": 1.0 + 0.05 * nrm(ks[5], (DEPTH, MIX_W), f32),
        "w_out": nrm(ks[6], (DEPTH, MIX_W, D_MODEL), f32) * MIX_W ** -0.5,
        "norm2_g": 1.0 + 0.05 * nrm(ks[7], (DEPTH, D_MODEL), f32),
        "w_router_group": nrm(ks[8], (DEPTH, D_MODEL, N_GROUPS), f32) * D_MODEL ** -0.5,
        "b_router_group": 0.01 * nrm(ks[9], (DEPTH, N_GROUPS), f32),
        "w_router_expert": nrm(ks[10], (DEPTH, D_MODEL, N_EXPERTS), f32) * D_MODEL ** -0.5,
        "b_router_expert": 0.01 * nrm(ks[11], (DEPTH, N_EXPERTS), f32),
        "w_gate": nrm(ks[12], (DEPTH, N_EXPERTS, D_MODEL, D_EXPERT), f32) * D_MODEL ** -0.5,
        "w_up": nrm(ks[13], (DEPTH, N_EXPERTS, D_MODEL, D_EXPERT), f32) * D_MODEL ** -0.5,
        "w_down": nrm(ks[14], (DEPTH, N_EXPERTS, D_EXPERT, D_MODEL), f32) * D_EXPERT ** -0.5,
    }


def reference(x, norm1_g, w_in, qk_norm_g, na_rpb, mix_norm_g, w_out, norm2_g,
              w_router_group, b_router_group, w_router_expert, b_router_expert,
              w_gate, w_up, w_down):
    for l in range(DEPTH):
        x = x + mixer_sublayer(x, norm1_g[l], w_in[l], qk_norm_g[l], na_rpb[l],
                               mix_norm_g[l], w_out[l])
        x = x + hier_moe(rms_norm(x, norm2_g[l]), w_router_group[l], b_router_group[l],
                         w_router_expert[l], b_router_expert[l],
                         w_gate[l], w_up[l], w_down[l])
    return x
```

```cpp
#include <hip/hip_runtime.h>
#include <cstdio>
#include <cstdint>

#ifndef MK_ONE_LAUNCH
#define MK_ONE_LAUNCH 0
#endif

#define LAS __attribute__((address_space(3)))
#define GAS __attribute__((address_space(1)))
typedef unsigned short bf16_t;
typedef short bf16x8 __attribute__((ext_vector_type(8)));
typedef short s16x4 __attribute__((ext_vector_type(4)));
typedef short v4i16_t __attribute__((ext_vector_type(4)));
typedef float f32x2 __attribute__((ext_vector_type(2)));
typedef float f32x4 __attribute__((ext_vector_type(4)));
typedef float f32x16 __attribute__((ext_vector_type(16)));
typedef unsigned u32x2 __attribute__((ext_vector_type(2)));
typedef unsigned u32x4 __attribute__((ext_vector_type(4)));
typedef __bf16 bf16x2_t __attribute__((ext_vector_type(2)));

constexpr int NTOK = 32768, DM = 1024, INC = 2304, NE = 32, DE = 512, DEPTH = 4, SEQ = 4096, BATCH = 8;
constexpr int NWAVES = 8, NTHR = 512;
constexpr float RMS_EPS = 1e-6f;
constexpr float LOG2E = 1.4426950408889634f;
constexpr float C2 = 0.125f * LOG2E;
constexpr int COL_QA = 0, COL_KA = 256, COL_VA = 512, COL_QB = 768, COL_KB = 1024, COL_VB = 1280, COL_QC = 1536, COL_KC = 2048, COL_VC = 2176;

constexpr size_t MiB = 1u << 20;
constexpr size_t WS_CTL = 0, CTL_ZERO_BYTES = 1 * MiB;
constexpr size_t WS_WIN = 2 * MiB;
constexpr size_t WS_WOUT = 20 * MiB;
constexpr size_t WS_WR = 28 * MiB;
constexpr size_t WS_ROPE = 29 * MiB;
constexpr size_t WS_WGU = 32 * MiB;
constexpr size_t WS_WD = 288 * MiB;
constexpr size_t WS_XB = 416 * MiB;
constexpr size_t WS_MB = 480 * MiB;
constexpr size_t WS_QKV = 544 * MiB;
constexpr size_t WS_OBUF = 688 * MiB;
constexpr size_t WS_LB = 784 * MiB;
constexpr size_t WS_RSTD1 = 786 * MiB;
constexpr size_t WS_RSTD2 = WS_RSTD1 + 256 * 1024;
constexpr size_t WS_SSQP = 787 * MiB;
constexpr size_t WS_LIST = 790 * MiB;
constexpr size_t WS_GLIST = 794 * MiB;
constexpr size_t WS_ASSIGN = 798 * MiB;
constexpr size_t WS_END = 800 * MiB;
constexpr size_t OB_A = 0, OB_C = (size_t)NTOK * 256 * 2, OB_B = OB_C + (size_t)NTOK * 512 * 2;
constexpr int CW_CNT = 1024;
constexpr int CW_BAR = 4096;

constexpr int LDS_BYTES = 147456;
constexpr int L_SCR = 0;
constexpr int L_MISC = 139264;
constexpr int L_BARW = 147456 - 64;

__device__ __forceinline__ int rfl(int v) { return __builtin_amdgcn_readfirstlane(v); }
__device__ __forceinline__ int otid() { int t = threadIdx.x; asm volatile("" : "+v"(t)); return t; }
template <class T> __device__ __forceinline__ T* oq(T* p) { asm volatile("" : "+s"(p)); return p; }
__device__ __forceinline__ unsigned pk2(float lo, float hi) { f32x2 v = {lo, hi}; bf16x2_t b = __builtin_convertvector(v, bf16x2_t); return __builtin_bit_cast(unsigned, b); }
__device__ __forceinline__ bf16_t f2bf(float f) { return (bf16_t)(pk2(f, 0.f) & 0xffffu); }
__device__ __forceinline__ float bflo(unsigned w) { return __uint_as_float(w << 16); }
__device__ __forceinline__ float bfhi(unsigned w) { return __uint_as_float(w & 0xffff0000u); }
__device__ __forceinline__ float wave_sum(float v) {
#pragma unroll
    for (int o = 1; o < 64; o <<= 1) v += __shfl_xor(v, o);
    return v;
}
__device__ __forceinline__ float wave_max(float v) {
#pragma unroll
    for (int o = 1; o < 64; o <<= 1) v = fmaxf(v, __shfl_xor(v, o));
    return v;
}
__device__ __forceinline__ int crow(int r, int hi) { return (r & 3) + 8 * (r >> 2) + 4 * hi; }
#define MFMA32(a, b, c) __builtin_amdgcn_mfma_f32_32x32x16_bf16((a), (b), (c), 0, 0, 0)
#define MFMA16(a, b, c) __builtin_amdgcn_mfma_f32_16x16x32_bf16((a), (b), (c), 0, 0, 0)
__device__ __forceinline__ s16x4 vtr(const LAS char* p) { return __builtin_bit_cast(s16x4, __builtin_amdgcn_ds_read_tr16_b64_v4i16((LAS v4i16_t*)p)); }

#define XB_TMO      128
#define XB_XCNT(j)  (256  + 64 * (j))
#define XB_XSUB(j)  (1280 + 64 * (j))
#define XB_XGEN(j)  (2304 + 64 * (j))
#define XB_TOP      3328
#define XB_TOPGEN   3392
#define XCD_BAR_WORDS 3456
#define XB_SPIN_CAP (1u << 18)
__device__ __forceinline__ unsigned xb_ld(unsigned* p)              { return __hip_atomic_load(p, __ATOMIC_RELAXED, __HIP_MEMORY_SCOPE_AGENT); }
__device__ __forceinline__ unsigned xb_add(unsigned* p, unsigned v) { return __hip_atomic_fetch_add(p, v, __ATOMIC_RELAXED, __HIP_MEMORY_SCOPE_AGENT); }
__device__ __forceinline__ unsigned xb_xcc_id() { return (unsigned)__builtin_amdgcn_s_getreg((3 << 11) | 20) & 0xFu; }
#define XB_SPIN(cond, bar) do { unsigned _sp = 0; while (cond) { __builtin_amdgcn_s_sleep(1); \
    if ((++_sp & 255u) == 0u) { if (xb_ld(&(bar)[XB_TMO])) break; if (_sp > XB_SPIN_CAP) { atomicAdd(&(bar)[XB_TMO], 1u); break; } } } } while (0)
struct XcdBarrier { unsigned* bar; unsigned x; volatile LAS unsigned* st; };
__device__ __forceinline__ XcdBarrier xcd_barrier_post(unsigned* bar, volatile LAS unsigned* st) {
    XcdBarrier b; b.bar = bar; b.x = xb_xcc_id(); b.st = st;
    if (threadIdx.x == 0) (void)xb_add(&bar[XB_XCNT(b.x)], 1u);
    return b;
}
__device__ __forceinline__ void xcd_barrier_complete(unsigned* bar, unsigned x, unsigned& nloc, unsigned& nx) {
    const unsigned G = gridDim.x * gridDim.y * gridDim.z;
    unsigned sum, cnt, mine, sp = 0u;
    for (;;) {
        sum = 0u; cnt = 0u; mine = 0u;
#pragma unroll
        for (unsigned j = 0; j < 16; ++j) { const unsigned c = xb_ld(&bar[XB_XCNT(j)]); sum += c; cnt += (c > 0u) ? 1u : 0u; mine = (j == x) ? c : mine; }
        if (sum == G) break;
        __builtin_amdgcn_s_sleep(1);
        if ((++sp & 255u) == 0u) { if (xb_ld(&bar[XB_TMO])) break; if (sp > XB_SPIN_CAP) { atomicAdd(&bar[XB_TMO], 1u); break; } }
    }
    nloc = mine > 0u ? mine : 1u; nx = cnt > 0u ? cnt : 1u;
}
__device__ __forceinline__ void xcd_barrier(const XcdBarrier& b) {
    asm volatile("s_waitcnt vmcnt(0)" ::: "memory");
    __syncthreads();
    if (threadIdx.x == 0) {
        unsigned* bar = b.bar;
        __builtin_amdgcn_s_waitcnt(0);
        unsigned nloc = b.st[0], nx = b.st[1];
        if (nloc == 0u) { xcd_barrier_complete(bar, b.x, nloc, nx); b.st[0] = nloc; b.st[1] = nx; }
        const unsigned old = xb_add(&bar[XB_XSUB(b.x)], 1u);
        const unsigned gen = old / nloc;
        if (old + 1u == (gen + 1u) * nloc) {
            __builtin_amdgcn_fence(__ATOMIC_RELEASE, "agent");
            asm volatile("s_waitcnt vmcnt(0)" ::: "memory");
            const unsigned og = xb_add(&bar[XB_TOP], 1u);
            const unsigned tg = og / nx;
            if (og + 1u == (tg + 1u) * nx) xb_add(&bar[XB_TOPGEN], 1u);
            else XB_SPIN(xb_ld(&bar[XB_TOPGEN]) == tg, bar);
            __builtin_amdgcn_fence(__ATOMIC_ACQUIRE, "agent");
            xb_add(&bar[XB_XGEN(b.x)], 1u);
            asm volatile("s_waitcnt vmcnt(0)" ::: "memory");
        } else {
            XB_SPIN(xb_ld(&bar[XB_XGEN(b.x)]) == gen, bar);
            __builtin_amdgcn_fence(__ATOMIC_ACQUIRE, "agent");
            asm volatile("s_waitcnt vmcnt(0)" ::: "memory");
        }
    }
    __syncthreads();
}

struct Args { const float* in[15]; float* out; unsigned char* ws; int ph_lo, ph_hi; };
enum { I_X = 0, I_N1G, I_WIN, I_QKG, I_RPB, I_MIXG, I_WOUT, I_N2G, I_WRG, I_BRG, I_WRE, I_BRE, I_WG, I_WU, I_WDN };

__device__ __forceinline__ int destrow(int mode, int c) {
    if (mode == 1) return (c & ~255) + ((c >> 5) & 1) * 128 + ((c >> 6) & 3) * 32 + (c & 31);
    if (mode == 2) return 256 * (c >> 7) + (c & 127);
    if (mode == 3) return 256 * (c >> 7) + 128 + (c & 127);
    return c;
}
__device__ __forceinline__ void tp_item(const float* W, int K, int N, bf16_t* WT, const float* kscale, int mode, LAS float* scr, int item, int lane) {
    const int nblk = N / 32, kb = item / nblk, nb = item % nblk, k0 = 64 * kb, n0 = 32 * nb;
#pragma unroll 8
    for (int i = 0; i < 32; ++i) { const int kk = 2 * i + (lane >> 5); const float s = kscale ? kscale[k0 + kk] : 1.f; scr[kk * 33 + (lane & 31)] = W[(size_t)(k0 + kk) * N + n0 + (lane & 31)] * s; }
    asm volatile("s_waitcnt lgkmcnt(0)" ::: "memory");
    const int c = lane & 7;
#pragma unroll
    for (int j = 0; j < 4; ++j) { const int n = (lane >> 3) + 8 * j; const LAS float* s = scr + (8 * c) * 33 + n;
        u32x4 o; o.x = pk2(s[0 * 33], s[1 * 33]); o.y = pk2(s[2 * 33], s[3 * 33]); o.z = pk2(s[4 * 33], s[5 * 33]); o.w = pk2(s[6 * 33], s[7 * 33]);
        *(u32x4*)(WT + (size_t)destrow(mode, n0 + n) * K + k0 + 8 * c) = o; }
    asm volatile("s_waitcnt lgkmcnt(0)" ::: "memory");
}
__device__ __forceinline__ void p0_prologue(const Args& a, LAS unsigned char* lds) {
    const int tid_ = otid(), lane = tid_ & 63, wave = rfl(tid_ >> 6);
    LAS float* scr = (LAS float*)(lds + wave * 16384);
    const int gw = blockIdx.x * NWAVES + wave, NGW = gridDim.x * NWAVES;
    unsigned char* ws = a.ws;
    constexpr int I_IN = 16 * 72, I_OUT = 16 * 32, I_E = 256, PER_L = I_IN + I_OUT + NE * 3 * I_E;
    for (int it = gw; it < DEPTH * PER_L; it += NGW) {
        const int l = it / PER_L; int r = it % PER_L;
        if (r < I_IN) { tp_item(a.in[I_WIN] + (size_t)l * DM * INC, DM, INC, (bf16_t*)(ws + WS_WIN) + (size_t)l * INC * DM, a.in[I_N1G] + l * DM, 1, scr, r, lane); continue; } r -= I_IN;
        if (r < I_OUT) { tp_item(a.in[I_WOUT] + (size_t)l * DM * DM, DM, DM, (bf16_t*)(ws + WS_WOUT) + (size_t)l * DM * DM, a.in[I_MIXG] + l * DM, 0, scr, r, lane); continue; } r -= I_OUT;
        const int e = r / (3 * I_E), rr = r % (3 * I_E), which = rr / I_E, item = rr % I_E; const size_t le = (size_t)l * NE + e;
        if (which == 0)      tp_item(a.in[I_WG] + le * DM * DE, DM, DE, (bf16_t*)(ws + WS_WGU) + le * DM * DM, a.in[I_N2G] + l * DM, 2, scr, item, lane);
        else if (which == 1) tp_item(a.in[I_WU] + le * DM * DE, DM, DE, (bf16_t*)(ws + WS_WGU) + le * DM * DM, a.in[I_N2G] + l * DM, 3, scr, item, lane);
        else                 tp_item(a.in[I_WDN] + le * DE * DM, DE, DM, (bf16_t*)(ws + WS_WD) + le * DM * DE, nullptr, 0, scr, item, lane);
    }
    const int gt = blockIdx.x * NTHR + tid_, NGT = gridDim.x * NTHR;
    for (int idx = gt; idx < DEPTH * 36 * DM; idx += NGT) {
        const int l = idx / (36 * DM), n = (idx / DM) % 36, k = idx % DM;
        const float w = (n < 4) ? a.in[I_WRG][((size_t)l * DM + k) * 4 + n] : a.in[I_WRE][((size_t)l * DM + k) * 32 + (n - 4)];
        ((bf16_t*)(ws + WS_WR))[((size_t)l * 64 + n) * DM + k] = f2bf(w * a.in[I_N2G][l * DM + k]);
    }
    if (gt < 64 * 16) {
        const int pos = gt >> 4, f = gt & 15;
        double inv = 1.0; for (int i = 0; i < f; ++i) inv *= 0.56234132519034908;
        const float invf = (float)inv; const float angf = (float)pos * invf;
        const double x = (double)angf;
        const double kq = __builtin_rint(x * 0.63661977236758134);
        const double rr = (x - kq * 1.5707963267341256) - kq * 6.0771005065061922e-11;
        const double r2 = rr * rr;
        double sn = rr * (1.0 + r2 * (-1.0 / 6 + r2 * (1.0 / 120 + r2 * (-1.0 / 5040 + r2 * (1.0 / 362880 + r2 * (-1.0 / 39916800 + r2 * (1.0 / 6227020800.0)))))));
        double cs = 1.0 + r2 * (-0.5 + r2 * (1.0 / 24 + r2 * (-1.0 / 720 + r2 * (1.0 / 40320 + r2 * (-1.0 / 3628800 + r2 * (1.0 / 479001600.0 + r2 * (-1.0 / 87178291200.0)))))));
        const int q = ((int)kq) & 3; double c, s;
        if (q == 0) { c = cs; s = sn; } else if (q == 1) { c = -sn; s = cs; } else if (q == 2) { c = -cs; s = -sn; } else { c = sn; s = -cs; }
        ((f32x2*)(ws + WS_ROPE))[gt] = (f32x2){(float)c, (float)s};
    }
}

constexpr int LM_CNT = L_MISC, LM_TPRE = L_MISC + 128, LM_TOKL = L_MISC + 512, LM_GL = L_MISC + 512 + 1024, LM_RC = L_MISC + 512 + 2048, LM_RB = LM_RC + 128;
__device__ __forceinline__ void moe_tables(const unsigned* ctl, int l, LAS unsigned char* lds) {
    LAS int* cnt = (LAS int*)(lds + LM_CNT); LAS int* tpre = (LAS int*)(lds + LM_TPRE);
    const int tid = otid();
    __syncthreads();
    if (tid < 32) cnt[tid] = (int)__hip_atomic_load(ctl + CW_CNT + 64 * l + tid, __ATOMIC_RELAXED, __HIP_MEMORY_SCOPE_AGENT);
    __syncthreads();
    if (tid == 0) { int s = 0; for (int e = 0; e < 32; ++e) { tpre[e] = s; s += (cnt[e] + 255) >> 8; } tpre[32] = s; }
    __syncthreads();
}

__device__ __forceinline__ void p_combine(const Args& a, int l, bool final_, LAS unsigned char* lds) {
    const int tid_ = otid(), lane = tid_ & 63, wave = rfl(tid_ >> 6);
    unsigned char* ws = oq(a.ws);
    const bool comb = (l > 0);
    const float* base = comb ? a.out : a.in[I_X];
    const bf16_t* Y = (const bf16_t*)(ws + WS_QKV);
    const int* assign = (const int*)(ws + WS_ASSIGN);
    bf16_t* xb = (bf16_t*)(ws + WS_XB); float* rstd1 = (float*)(ws + WS_RSTD1);
    if (comb) moe_tables((const unsigned*)(ws + WS_CTL), l - 1, lds);
    const LAS int* tpre = (const LAS int*)(lds + LM_TPRE);
    const int gw = blockIdx.x * NWAVES + wave, NGW = gridDim.x * NWAVES;
    for (int row = gw; row < NTOK; row += NGW) {
        f32x4 v[4];
#pragma unroll
        for (int j = 0; j < 4; ++j) v[j] = *(const f32x4*)(base + (size_t)row * DM + 4 * lane + 256 * j);
        if (comb) {
            const int e0 = assign[row * 4 + 0], r0 = assign[row * 4 + 1], e1 = assign[row * 4 + 2], r1 = assign[row * 4 + 3];
            const size_t s0 = (size_t)tpre[e0] * 256 + r0, s1 = (size_t)tpre[e1] * 256 + r1;
#pragma unroll
            for (int j = 0; j < 4; ++j) {
                const u32x2 y0 = *(const u32x2*)(Y + s0 * DM + 4 * lane + 256 * j), y1 = *(const u32x2*)(Y + s1 * DM + 4 * lane + 256 * j);
                v[j].x += bflo(y0.x) + bflo(y1.x); v[j].y += bfhi(y0.x) + bfhi(y1.x); v[j].z += bflo(y0.y) + bflo(y1.y); v[j].w += bfhi(y0.y) + bfhi(y1.y);
            }
#pragma unroll
            for (int j = 0; j < 4; ++j) *(f32x4*)(a.out + (size_t)row * DM + 4 * lane + 256 * j) = v[j];
        }
        if (!final_) {
            float s = 0.f;
#pragma unroll
            for (int j = 0; j < 4; ++j) s += (v[j].x * v[j].x + v[j].y * v[j].y) + (v[j].z * v[j].z + v[j].w * v[j].w);
            s = wave_sum(s);
            if (lane == 0) rstd1[row] = 1.f / sqrtf(s * (1.f / DM) + RMS_EPS);
#pragma unroll
            for (int j = 0; j < 4; ++j) { u32x2 o; o.x = pk2(v[j].x, v[j].y); o.y = pk2(v[j].z, v[j].w); *(u32x2*)(xb + (size_t)row * DM + 4 * lane + 256 * j) = o; }
        }
    }
}

struct GUnit { int pm, pn, e, T; };
constexpr int G_AS = 0, G_BS = 20480, G_ROWB = 80;
template <class Sched, class Epi>
__device__ __forceinline__ void gemm_simple(LAS unsigned char* lds, const Sched& S, const Epi& E, const int K) {
    const int tid = otid(), wid = rfl(tid >> 6), lane = tid & 63, wr = wid >> 2, wc = wid & 3, fr = lane & 15, fq = lane >> 4;
    GUnit u;
    for (int ui = 0; S.next(ui, u, lds); ++ui) {
        S.begin(u, lds);
        const bf16_t* ap[2]; const bf16_t* bp[2]; bool bv[2];
        const int nbv = S.b_valid(u);
#pragma unroll
        for (int i = 0; i < 2; ++i) { const int r = (tid >> 2) + 128 * i; ap[i] = S.a_row(u, r, lds) + (tid & 3) * 8; bp[i] = S.b_row(u, r) + (tid & 3) * 8; bv[i] = r < nbv; }
        f32x4 acc[2][2][4][2];
#pragma unroll
        for (int x = 0; x < 2; ++x)
#pragma unroll
            for (int y = 0; y < 2; ++y)
#pragma unroll
                for (int m = 0; m < 4; ++m)
#pragma unroll
                    for (int n = 0; n < 2; ++n) acc[x][y][m][n] = (f32x4){0.f, 0.f, 0.f, 0.f};
        for (int kt = 0; kt < K / 32; ++kt) {
            u32x4 ra[2], rb[2];
#pragma unroll
            for (int i = 0; i < 2; ++i) { ra[i] = *(const u32x4*)(ap[i] + kt * 32); rb[i] = bv[i] ? *(const u32x4*)(bp[i] + kt * 32) : (u32x4){0u, 0u, 0u, 0u}; }
            __syncthreads();
#pragma unroll
            for (int i = 0; i < 2; ++i) { const int r = (tid >> 2) + 128 * i;
                *(LAS u32x4*)(lds + G_AS + r * G_ROWB + (tid & 3) * 16) = ra[i];
                *(LAS u32x4*)(lds + G_BS + r * G_ROWB + (tid & 3) * 16) = rb[i]; }
            __syncthreads();
#pragma unroll
            for (int ai = 0; ai < 2; ++ai) {
                bf16x8 At[4];
#pragma unroll
                for (int m = 0; m < 4; ++m) At[m] = *(const LAS bf16x8*)(lds + G_AS + (128 * ai + 64 * wr + 16 * m + fr) * G_ROWB + 16 * fq);
#pragma unroll
                for (int bj = 0; bj < 2; ++bj) {
                    bf16x8 Bt[2];
#pragma unroll
                    for (int n = 0; n < 2; ++n) Bt[n] = *(const LAS bf16x8*)(lds + G_BS + (128 * bj + 32 * wc + 16 * n + fr) * G_ROWB + 16 * fq);
#pragma unroll
                    for (int m = 0; m < 4; ++m)
#pragma unroll
                        for (int n = 0; n < 2; ++n) acc[ai][bj][m][n] = MFMA16(Bt[n], At[m], acc[ai][bj][m][n]);
                }
            }
        }
        E(acc, u, lds, wid, lane);
    }
}

struct DenseSched {
    const bf16_t* A; int lda; const bf16_t* Bt; int ldb; int nM, nN, nvalid;
    __device__ __forceinline__ bool next(int i, GUnit& u, LAS unsigned char*) const { const int L = i * (int)gridDim.x + (int)blockIdx.x; if (L >= nM * nN) return false; u.pm = L / nN; u.pn = L % nN; u.e = 0; u.T = 0; return true; }
    __device__ __forceinline__ void begin(const GUnit&, LAS unsigned char*) const {}
    __device__ __forceinline__ const bf16_t* a_row(const GUnit& u, int r, LAS unsigned char*) const { return A + (size_t)(256 * u.pm + r) * lda; }
    __device__ __forceinline__ const bf16_t* b_row(const GUnit& u, int r) const { return Bt + (size_t)(256 * u.pn + r) * ldb; }
    __device__ __forceinline__ int b_valid(const GUnit& u) const { return nvalid - 256 * u.pn; }
};
struct MoeSched {
    const bf16_t* A; int lda; const bf16_t* Bt; size_t bstride; int ldb; const int* list; const float* glist; bool gather;
    __device__ __forceinline__ bool next(int i, GUnit& u, LAS unsigned char* lds) const {
        const LAS int* tpre = (const LAS int*)(lds + LM_TPRE);
        const int idx = i * (int)gridDim.x + (int)blockIdx.x; if (idx >= 4 * tpre[32]) return false;
        const int T = idx >> 2; int e = 0;
        for (int k = 1; k < 32; ++k) e += (tpre[k] <= T) ? 1 : 0;
        u.e = e; u.T = T; u.pm = T - tpre[e]; u.pn = idx & 3; return true;
    }
    __device__ __forceinline__ void begin(const GUnit& u, LAS unsigned char* lds) const {
        const LAS int* cnt = (const LAS int*)(lds + LM_CNT); LAS int* tokl = (LAS int*)(lds + LM_TOKL); LAS float* gl = (LAS float*)(lds + LM_GL);
        const int tid = otid();
        __syncthreads();
        if (tid < 256) { const int idx = 256 * u.pm + tid; const bool v = idx < cnt[u.e];
            tokl[tid] = v ? list[u.e * NTOK + idx] : 0; gl[tid] = v ? glist[u.e * NTOK + idx] : 0.f; }
        __syncthreads();
    }
    __device__ __forceinline__ const bf16_t* a_row(const GUnit& u, int r, LAS unsigned char* lds) const {
        if (gather) { const LAS int* tokl = (const LAS int*)(lds + LM_TOKL); return A + (size_t)tokl[r] * lda; }
        return A + ((size_t)256 * u.T + r) * lda;
    }
    __device__ __forceinline__ const bf16_t* b_row(const GUnit& u, int r) const { return Bt + (size_t)u.e * bstride + (size_t)(256 * u.pn + r) * ldb; }
    __device__ __forceinline__ int b_valid(const GUnit&) const { return 256; }
};

struct EpiQKV {
    const float* rstd1; const float* qkg  ; const f32x2* rope; bf16_t* qkv;
    __device__ __forceinline__ void operator()(const f32x4 (&acc)[2][2][4][2], const GUnit& u, LAS unsigned char*, int wid, int lane) const {
        const int wr = wid >> 2, wc = wid & 3, fr = lane & 15, fq = lane >> 4;
        const int colbase = 256 * u.pn + 64 * wc;
        int mixer = -1, qk = 0;
        if (colbase < COL_KA) { mixer = 0; qk = 0; } else if (colbase < COL_VA) { mixer = 0; qk = 1; } else if (colbase < COL_QB) { mixer = -1; }
        else if (colbase < COL_KB) { mixer = 1; qk = 0; } else if (colbase < COL_VB) { mixer = 1; qk = 1; } else if (colbase < COL_QC) { mixer = -1; }
        else if (colbase < COL_KC) { mixer = 2; qk = 0; } else if (colbase < COL_VC) { mixer = 2; qk = 1; } else { mixer = -1; }
        f32x4 g[2][2];
        if (mixer >= 0) {
#pragma unroll
            for (int bj = 0; bj < 2; ++bj)
#pragma unroll
                for (int n = 0; n < 2; ++n) g[bj][n] = *(const f32x4*)(qkg + (mixer * 2 + qk) * 64 + 32 * bj + 16 * n + 4 * fq);
        }
#pragma unroll
        for (int ai = 0; ai < 2; ++ai)
#pragma unroll
            for (int m = 0; m < 4; ++m) {
                const int row = 256 * u.pm + 128 * ai + 64 * wr + 16 * m + fr;
                const float rs = rstd1[row];
                f32x4 v[2][2];
#pragma unroll
                for (int bj = 0; bj < 2; ++bj)
#pragma unroll
                    for (int n = 0; n < 2; ++n) v[bj][n] = acc[ai][bj][m][n] * rs;
                if (mixer >= 0) {
                    float ss = 0.f;
#pragma unroll
                    for (int bj = 0; bj < 2; ++bj)
#pragma unroll
                        for (int n = 0; n < 2; ++n) ss += (v[bj][n].x * v[bj][n].x + v[bj][n].y * v[bj][n].y) + (v[bj][n].z * v[bj][n].z + v[bj][n].w * v[bj][n].w);
                    ss += __shfl_xor(ss, 16); ss += __shfl_xor(ss, 32);
                    const float inv = 1.f / sqrtf(ss * (1.f / 64.f) + RMS_EPS);
#pragma unroll
                    for (int bj = 0; bj < 2; ++bj)
#pragma unroll
                        for (int n = 0; n < 2; ++n) v[bj][n] = v[bj][n] * inv * g[bj][n];
                    if (mixer == 2) {
                        const int t = row & (SEQ - 1);
#pragma unroll
                        for (int bj = 0; bj < 2; ++bj) {
                            const int pos = (bj == 0) ? (t >> 6) : (t & 63);
#pragma unroll
                            for (int i = 0; i < 4; ++i) { const f32x2 cs = rope[pos * 16 + 4 * fq + i]; const float x1 = v[bj][0][i], x2 = v[bj][1][i];
                                v[bj][0][i] = x1 * cs.x - x2 * cs.y; v[bj][1][i] = x2 * cs.x + x1 * cs.y; }
                        }
                    }
                    if (qk == 0) {
#pragma unroll
                        for (int bj = 0; bj < 2; ++bj)
#pragma unroll
                            for (int n = 0; n < 2; ++n) v[bj][n] = v[bj][n] * C2;
                    }
                }
#pragma unroll
                for (int bj = 0; bj < 2; ++bj)
#pragma unroll
                    for (int n = 0; n < 2; ++n) { u32x2 o; o.x = pk2(v[bj][n].x, v[bj][n].y); o.y = pk2(v[bj][n].z, v[bj][n].w);
                        *(u32x2*)(qkv + (size_t)row * INC + colbase + 32 * bj + 16 * n + 4 * fq) = o; }
            }
    }
};
struct EpiWout {
    const float* base; float* out; bf16_t* xb; float* ssqp;
    __device__ __forceinline__ void operator()(const f32x4 (&acc)[2][2][4][2], const GUnit& u, LAS unsigned char*, int wid, int lane) const {
        const int wr = wid >> 2, wc = wid & 3, fr = lane & 15, fq = lane >> 4;
#pragma unroll
        for (int ai = 0; ai < 2; ++ai)
#pragma unroll
            for (int m = 0; m < 4; ++m) {
                const int row = 256 * u.pm + 128 * ai + 64 * wr + 16 * m + fr; float ss = 0.f;
#pragma unroll
                for (int bj = 0; bj < 2; ++bj)
#pragma unroll
                    for (int n = 0; n < 2; ++n) { const size_t off = (size_t)row * DM + 256 * u.pn + 128 * bj + 32 * wc + 16 * n + 4 * fq;
                        const f32x4 x1 = *(const f32x4*)(base + off) + acc[ai][bj][m][n];
                        *(f32x4*)(out + off) = x1; u32x2 o; o.x = pk2(x1.x, x1.y); o.y = pk2(x1.z, x1.w); *(u32x2*)(xb + off) = o;
                        ss += (x1.x * x1.x + x1.y * x1.y) + (x1.z * x1.z + x1.w * x1.w); }
                ss += __shfl_xor(ss, 16); ss += __shfl_xor(ss, 32);
                if (fq == 0) ssqp[(size_t)row * 16 + 4 * u.pn + wc] = ss;
            }
    }
};
constexpr int LR_LOGIT = 81920;
struct EpiRouter {
    const float* ssqp; float* rstd2; const float* brg; const float* bre; unsigned* cntg; int* list; float* glist; int* assign;
    __device__ __forceinline__ void operator()(const f32x4 (&acc)[2][2][4][2], const GUnit& u, LAS unsigned char* lds, int wid, int lane) const {
        const int wr = wid >> 2, wc = wid & 3, fr = lane & 15, fq = lane >> 4, tid = wid * 64 + lane;
        LAS float* lg = (LAS float*)(lds + LR_LOGIT); LAS int* rc = (LAS int*)(lds + LM_RC); LAS int* rb = (LAS int*)(lds + LM_RB);
        if (wc < 2) {
#pragma unroll
            for (int ai = 0; ai < 2; ++ai)
#pragma unroll
                for (int m = 0; m < 4; ++m)
#pragma unroll
                    for (int n = 0; n < 2; ++n)
#pragma unroll
                        for (int i = 0; i < 4; ++i) { const int c = 32 * wc + 16 * n + 4 * fq + i; if (c < 36) lg[(128 * ai + 64 * wr + 16 * m + fr) * 40 + c] = acc[ai][0][m][n][i]; }
        }
        if (tid < 32) rc[tid] = 0;
        __syncthreads();
        int e0 = 0, e1 = 0, r0 = 0, r1 = 0; float g0 = 0.f, g1 = 0.f; const int row = 256 * u.pm + tid;
        if (tid < 256) {
            float ss = 0.f;
#pragma unroll
            for (int j = 0; j < 16; ++j) ss += ssqp[(size_t)row * 16 + j];
            const float rs = 1.f / sqrtf(ss * (1.f / DM) + RMS_EPS); rstd2[row] = rs;
            float gl[4]; int grp = 0;
#pragma unroll
            for (int j = 0; j < 4; ++j) gl[j] = lg[tid * 40 + j] * rs + brg[j];
            float gm = gl[0];
#pragma unroll
            for (int j = 1; j < 4; ++j) if (gl[j] > gm) { gm = gl[j]; grp = j; }
            float den = 0.f;
#pragma unroll
            for (int j = 0; j < 4; ++j) den += __expf(gl[j] - gm);
            const float pgrp = 1.f / den;
            float el[8];
#pragma unroll
            for (int j = 0; j < 8; ++j) el[j] = lg[tid * 40 + 4 + 8 * grp + j] * rs + bre[8 * grp + j];
            int i0 = 0; float v0 = el[0];
#pragma unroll
            for (int j = 1; j < 8; ++j) if (el[j] > v0) { v0 = el[j]; i0 = j; }
            int i1 = -1; float v1 = 0.f;
#pragma unroll
            for (int j = 0; j < 8; ++j) if (j != i0 && (i1 < 0 || el[j] > v1)) { v1 = el[j]; i1 = j; }
            const float ex = __expf(v1 - v0); const float w0 = 1.f / (1.f + ex);
            g0 = pgrp * w0; g1 = pgrp * (ex * w0);
            e0 = 8 * grp + i0; e1 = 8 * grp + i1;
            r0 = __hip_atomic_fetch_add(rc + e0, 1, __ATOMIC_RELAXED, __HIP_MEMORY_SCOPE_WORKGROUP);
            r1 = __hip_atomic_fetch_add(rc + e1, 1, __ATOMIC_RELAXED, __HIP_MEMORY_SCOPE_WORKGROUP);
        }
        __syncthreads();
        if (tid < 32) { const int c = rc[tid]; rb[tid] = c ? (int)__hip_atomic_fetch_add(cntg + tid, (unsigned)c, __ATOMIC_RELAXED, __HIP_MEMORY_SCOPE_AGENT) : 0; }
        __syncthreads();
        if (tid < 256) {
            r0 += rb[e0]; r1 += rb[e1];
            list[e0 * NTOK + r0] = row; glist[e0 * NTOK + r0] = g0;
            list[e1 * NTOK + r1] = row; glist[e1 * NTOK + r1] = g1;
            *(int4*)(assign + row * 4) = make_int4(e0, r0, e1, r1);
        }
        __syncthreads();
    }
};
struct EpiGU {
    const float* rstd2; bf16_t* H;
    __device__ __forceinline__ void operator()(const f32x4 (&acc)[2][2][4][2], const GUnit& u, LAS unsigned char* lds, int wid, int lane) const {
        const int wr = wid >> 2, wc = wid & 3, fr = lane & 15, fq = lane >> 4;
        const LAS int* tokl = (const LAS int*)(lds + LM_TOKL);
#pragma unroll
        for (int ai = 0; ai < 2; ++ai)
#pragma unroll
            for (int m = 0; m < 4; ++m) {
                const int rl = 128 * ai + 64 * wr + 16 * m + fr; const float rs = rstd2[tokl[rl]];
#pragma unroll
                for (int n = 0; n < 2; ++n) { const f32x4 g = acc[ai][0][m][n] * rs, up = acc[ai][1][m][n] * rs; f32x4 h;
#pragma unroll
                    for (int i = 0; i < 4; ++i) h[i] = g[i] / (1.f + __expf(-g[i])) * up[i];
                    u32x2 o; o.x = pk2(h.x, h.y); o.y = pk2(h.z, h.w);
                    *(u32x2*)(H + ((size_t)256 * u.T + rl) * DE + 128 * u.pn + 32 * wc + 16 * n + 4 * fq) = o; }
            }
    }
};
struct EpiDown {
    bf16_t* Y;
    __device__ __forceinline__ void operator()(const f32x4 (&acc)[2][2][4][2], const GUnit& u, LAS unsigned char* lds, int wid, int lane) const {
        const int wr = wid >> 2, wc = wid & 3, fr = lane & 15, fq = lane >> 4;
        const LAS float* gl = (const LAS float*)(lds + LM_GL);
#pragma unroll
        for (int ai = 0; ai < 2; ++ai)
#pragma unroll
            for (int m = 0; m < 4; ++m) {
                const int rl = 128 * ai + 64 * wr + 16 * m + fr; const float gt = gl[rl];
#pragma unroll
                for (int bj = 0; bj < 2; ++bj)
#pragma unroll
                    for (int n = 0; n < 2; ++n) { const f32x4 y = acc[ai][bj][m][n] * gt; u32x2 o; o.x = pk2(y.x, y.y); o.y = pk2(y.z, y.w);
                        *(u32x2*)(Y + ((size_t)256 * u.T + rl) * DM + 256 * u.pn + 128 * bj + 32 * wc + 16 * n + 4 * fq) = o; }
            }
    }
};

template <int KS, int VS, class MaskF>
__device__ __forceinline__ void attn_tile32(const bf16x8 (&qf)[4], const LAS char* Kt, const LAS char* Vt, f32x16 (&o)[2], float& lsum, int lane, const MaskF& mf) {
    const int r32 = lane & 31, hi = lane >> 5;
    f32x16 s;
#pragma unroll
    for (int r = 0; r < 16; ++r) s[r] = 0.f;
#pragma unroll
    for (int d0 = 0; d0 < 4; ++d0) { const bf16x8 kf = *(const LAS bf16x8*)(Kt + r32 * KS + (16 * d0 + 8 * hi) * 2); s = MFMA32(kf, qf[d0], s); }
    float ps = 0.f;
#pragma unroll
    for (int r = 0; r < 16; ++r) { const float p = mf(s[r], crow(r, hi)); s[r] = p; ps += p; }
    lsum += ps;
    u32x4 pw0, pw1;
    pw0.x = pk2(s[0], s[1]); pw0.y = pk2(s[2], s[3]); pw0.z = pk2(s[4], s[5]); pw0.w = pk2(s[6], s[7]);
    pw1.x = pk2(s[8], s[9]); pw1.y = pk2(s[10], s[11]); pw1.z = pk2(s[12], s[13]); pw1.w = pk2(s[14], s[15]);
    const LAS char* vb = Vt + (4 * hi + ((lane & 15) >> 2)) * VS + ((lane >> 4) & 1) * 32 + (lane & 3) * 8;
#pragma unroll
    for (int d0 = 0; d0 < 2; ++d0) {
#pragma unroll
        for (int st = 0; st < 2; ++st) {
            const s16x4 lo = vtr(vb + (16 * st) * VS + d0 * 64), h4 = vtr(vb + (16 * st + 8) * VS + d0 * 64);
            const bf16x8 vf = {lo[0], lo[1], lo[2], lo[3], h4[0], h4[1], h4[2], h4[3]};
            o[d0] = MFMA32(__builtin_bit_cast(bf16x8, st == 0 ? pw0 : pw1), vf, o[d0]);
        }
    }
}
struct TokLin { size_t base; __device__ __forceinline__ size_t operator()(int q) const { return base + q; } };
struct TokDil { size_t base; int dil; __device__ __forceinline__ size_t operator()(int q) const { return base + (size_t)dil * q; } };
template <class TokF>
__device__ __forceinline__ void store_o(const f32x16 (&o)[2], float sc, bf16_t* dst, int ld, int lane, const TokF& tokf) {
    const int r32 = lane & 31, hi = lane >> 5;
#pragma unroll
    for (int r = 0; r < 16; ++r) { const int q = crow(r, hi); const float f = __shfl(sc, q); const size_t off = (size_t)tokf(q) * ld + r32;
        dst[off] = f2bf(o[0][r] * f); dst[off + 32] = f2bf(o[1][r] * f); }
}
__device__ __forceinline__ float gain_bound(const float* g  , int lane) { return wave_max(fabsf(g[lane])) * wave_max(fabsf(g[64 + lane])); }

struct MaskA { const LAS float* tab; int qc, cs, ch; float mref;
    __device__ __forceinline__ float operator()(float s, int key) const { const int kc = 32 * ch + key; const bool v = (kc >= cs) && (kc < cs + 16);
        int dc = kc - qc + 15; dc = dc < 0 ? 0 : (dc > 30 ? 30 : dc); const float b = tab[dc];
        return v ? __builtin_amdgcn_exp2f(s + b - mref) : 0.f; } };
__device__ __forceinline__ void p_attn_a(const Args& a, int l, LAS unsigned char* lds) {
    const int tid = otid(), lane = tid & 63, wave = rfl(tid >> 6);
    constexpr int KS = 144, VS = 128, L_K = 0, L_V = 512 * KS;
    const bf16_t* qkv = (const bf16_t*)(a.ws + WS_QKV); bf16_t* oA = (bf16_t*)(a.ws + WS_OBUF + OB_A);
    const float* rpb = a.in[I_RPB] + (size_t)l * 4 * 15 * 31;
    LAS float* tab = (LAS float*)(lds + L_MISC);
    const int r32 = lane & 31, hi = lane >> 5;
    __syncthreads();
    float mx = 0.f;
    for (int i = tid; i < 1860; i += NTHR) tab[i] = rpb[i] * LOG2E;
    for (int i = lane; i < 1860; i += 64) mx = fmaxf(mx, fabsf(rpb[i]));
    mx = wave_max(mx);
    const float mref = (8.f * gain_bound(a.in[I_QKG] + (size_t)l * 384 + 0, lane) + mx) * LOG2E;
    __syncthreads();
    const int qh = wave & 1, kp = wave >> 1;
    for (int unit = blockIdx.x; unit < BATCH * 4 * 64; unit += gridDim.x) {
        const int b = unit >> 8, h = (unit >> 6) & 3, r = unit & 63;
        int r0 = r - 4; r0 = r0 < 0 ? 0 : (r0 > 56 ? 56 : r0);
        const size_t tok0 = (size_t)b * SEQ + r0 * 64;
#pragma unroll
        for (int i = 0; i < 8; ++i) { const int row = 64 * i + (tid >> 3), ch = tid & 7;
            const u32x4 kv = *(const u32x4*)(qkv + (tok0 + row) * INC + COL_KA + 64 * h + 8 * ch), vv = *(const u32x4*)(qkv + (tok0 + row) * INC + COL_VA + 64 * h + 8 * ch);
            *(LAS u32x4*)(lds + L_K + row * KS + ch * 16) = kv; *(LAS u32x4*)(lds + L_V + row * VS + ch * 16) = vv; }
        const size_t tokq = (size_t)b * SEQ + r * 64 + 32 * qh;
        bf16x8 qf[4];
#pragma unroll
        for (int d0 = 0; d0 < 4; ++d0) qf[d0] = *(const bf16x8*)(qkv + (tokq + r32) * INC + COL_QA + 64 * h + 16 * d0 + 8 * hi);
        __syncthreads();
        f32x16 o[2]; float lsum = 0.f;
#pragma unroll
        for (int r_ = 0; r_ < 16; ++r_) { o[0][r_] = 0.f; o[1][r_] = 0.f; }
        const int qc = 32 * qh + r32; int cs = qc - 8; cs = cs < 0 ? 0 : (cs > 48 ? 48 : cs);
#pragma unroll 1
        for (int t = 0; t < 4; ++t) { const int kr = 2 * kp + (t >> 1), ch = t & 1;
            MaskA mf{tab + h * 465 + (r0 + kr - r + 7) * 31, qc, cs, ch, mref};
            attn_tile32<KS, VS>(qf, (const LAS char*)(lds + L_K + (kr * 64 + 32 * ch) * KS), (const LAS char*)(lds + L_V + (kr * 64 + 32 * ch) * VS), o, lsum, lane, mf); }
        __syncthreads();
        LAS float* mb = (LAS float*)(lds + L_K);
#pragma unroll
        for (int r_ = 0; r_ < 16; ++r_) { mb[(wave * 33 + r_) * 64 + lane] = o[0][r_]; mb[(wave * 33 + 16 + r_) * 64 + lane] = o[1][r_]; }
        mb[(wave * 33 + 32) * 64 + lane] = lsum;
        __syncthreads();
        if (kp == 0) {
#pragma unroll
            for (int w2 = 2; w2 < 8; w2 += 2) {
#pragma unroll
                for (int r_ = 0; r_ < 16; ++r_) { o[0][r_] += mb[((wave + w2) * 33 + r_) * 64 + lane]; o[1][r_] += mb[((wave + w2) * 33 + 16 + r_) * 64 + lane]; }
                lsum += mb[((wave + w2) * 33 + 32) * 64 + lane];
            }
            lsum += __shfl_xor(lsum, 32);
            store_o(o, 1.f / lsum, oA + 64 * h, 256, lane, TokLin{tokq});
        }
        __syncthreads();
    }
}

struct MaskB { int dbase, ukey0, L; float slope2, mref; int r32;
    __device__ __forceinline__ float operator()(float s, int key) const { const int delta = dbase + key - r32, up = ukey0 + key; const int ad = delta < 0 ? -delta : delta;
        const bool v = (ad <= 64) && (up >= 0) && (up < L);
        return v ? __builtin_amdgcn_exp2f(s - slope2 * (float)ad - mref) : 0.f; } };
__device__ __forceinline__ void p_attn_b(const Args& a, int l, LAS unsigned char* lds) {
    const int tid = otid(), lane = tid & 63, wave = rfl(tid >> 6);
    constexpr int KS = 144, VS = 128, NK = 384, L_K = 0, L_V = NK * KS;
    const bf16_t* qkv = (const bf16_t*)(a.ws + WS_QKV); bf16_t* oB = (bf16_t*)(a.ws + WS_OBUF + OB_B); float* lB = (float*)(a.ws + WS_LB);
    const int r32 = lane & 31, hi = lane >> 5;
    const float mref = 8.f * gain_bound(a.in[I_QKG] + (size_t)l * 384 + 128, lane) * LOG2E;
    for (int unit = blockIdx.x; unit < BATCH * 4 * 48; unit += gridDim.x) {
        const int b = unit / 192, rem = unit % 192, h = rem / 48, w48 = rem % 48, br = w48 >> 4, sub = w48 & 15;
        const int dil = (br == 0) ? 1 : (br == 1 ? 4 : 16), L = SEQ / dil;
        const int rho = sub % dil, ub = sub / dil, u0 = 256 * ub;
        const size_t tokb = (size_t)b * SEQ;
        __syncthreads();
#pragma unroll
        for (int i = 0; i < 6; ++i) { const int idx = tid + NTHR * i, row = idx >> 3, ch = idx & 7; const int up = u0 - 64 + row;
            u32x4 kv = {0u, 0u, 0u, 0u}, vv = {0u, 0u, 0u, 0u};
            if (up >= 0 && up < L) { const size_t tok = tokb + (size_t)dil * up + rho; kv = *(const u32x4*)(qkv + tok * INC + COL_KB + 64 * h + 8 * ch); vv = *(const u32x4*)(qkv + tok * INC + COL_VB + 64 * h + 8 * ch); }
            *(LAS u32x4*)(lds + L_K + row * KS + ch * 16) = kv; *(LAS u32x4*)(lds + L_V + row * VS + ch * 16) = vv; }
        const int uq = u0 + 32 * wave;
        bf16x8 qf[4];
#pragma unroll
        for (int d0 = 0; d0 < 4; ++d0) qf[d0] = *(const bf16x8*)(qkv + (tokb + (size_t)dil * (uq + r32) + rho) * INC + COL_QB + 64 * h + 16 * d0 + 8 * hi);
        __syncthreads();
        f32x16 o[2]; float lsum = 0.f;
#pragma unroll
        for (int r_ = 0; r_ < 16; ++r_) { o[0][r_] = 0.f; o[1][r_] = 0.f; }
        const float slope2 = exp2f(-2.f * (float)(h + 1)) * (float)dil * LOG2E;
#pragma unroll 1
        for (int j = 0; j < 5; ++j) { const int krow = 32 * wave + 32 * j;
            MaskB mf{32 * j - 64, uq - 64 + 32 * j, L, slope2, mref, r32};
            attn_tile32<KS, VS>(qf, (const LAS char*)(lds + L_K + krow * KS), (const LAS char*)(lds + L_V + krow * VS), o, lsum, lane, mf); }
        lsum += __shfl_xor(lsum, 32);
        store_o(o, 1.f, oB + (size_t)br * NTOK * 256 + 64 * h, 256, lane, TokDil{tokb + (size_t)dil * uq + rho, dil});
        if (hi == 0) lB[(tokb + (size_t)dil * (uq + r32) + rho) * 16 + 4 * h + br] = lsum;
    }
}

struct MaskC { float mref; __device__ __forceinline__ float operator()(float s, int) const { return __builtin_amdgcn_exp2f(s - mref); } };
__device__ __forceinline__ void p_attn_c(const Args& a, int l, LAS unsigned char* lds) {
    const int tid = otid(), lane = tid & 63, wave = rfl(tid >> 6);
    constexpr int KS = 144, VS = 128, KB = 64 * KS, VB = 64 * VS, L_K = 0, L_V = 2 * KB;
    const bf16_t* qkv = (const bf16_t*)(a.ws + WS_QKV); bf16_t* oC = (bf16_t*)(a.ws + WS_OBUF + OB_C);
    const int r32 = lane & 31, hi = lane >> 5;
    const float mref = 8.f * gain_bound(a.in[I_QKG] + (size_t)l * 384 + 256, lane) * LOG2E;
    const MaskC mf{mref};
    for (int unit = blockIdx.x; unit < BATCH * 2 * 64; unit += gridDim.x) {
        const int b = unit >> 7, kvh = (unit >> 6) & 1, qb = unit & 63;
        const int head = 4 * kvh + (wave >> 1);
        const size_t tokb = (size_t)b * SEQ, tokq = tokb + 64 * qb + 32 * (wave & 1);
        bf16x8 qf[4];
#pragma unroll
        for (int d0 = 0; d0 < 4; ++d0) qf[d0] = *(const bf16x8*)(qkv + (tokq + r32) * INC + COL_QC + 64 * head + 16 * d0 + 8 * hi);
        const bf16_t* ksrc = qkv + (tokb + (tid >> 3)) * INC + COL_KC + 64 * kvh + 8 * (tid & 7);
        const bf16_t* vsrc = qkv + (tokb + (tid >> 3)) * INC + COL_VC + 64 * kvh + 8 * (tid & 7);
        const int kdst = L_K + (tid >> 3) * KS + (tid & 7) * 16, vdst = L_V + (tid >> 3) * VS + (tid & 7) * 16;
        u32x4 rk = *(const u32x4*)ksrc, rv = *(const u32x4*)vsrc;
        __syncthreads();
        *(LAS u32x4*)(lds + kdst) = rk; *(LAS u32x4*)(lds + vdst) = rv;
        __syncthreads();
        f32x16 o[2]; float lsum = 0.f;
#pragma unroll
        for (int r_ = 0; r_ < 16; ++r_) { o[0][r_] = 0.f; o[1][r_] = 0.f; }
        for (int t = 0; t < SEQ / 64; ++t) {
            const int cur = t & 1;
            if (t + 1 < SEQ / 64) { rk = *(const u32x4*)(ksrc + (size_t)(t + 1) * 64 * INC); rv = *(const u32x4*)(vsrc + (size_t)(t + 1) * 64 * INC); }
#pragma unroll
            for (int sub = 0; sub < 2; ++sub)
                attn_tile32<KS, VS>(qf, (const LAS char*)(lds + L_K + cur * KB + 32 * sub * KS), (const LAS char*)(lds + L_V + cur * VB + 32 * sub * VS), o, lsum, lane, mf);
            if (t + 1 < SEQ / 64) { *(LAS u32x4*)(lds + kdst + (cur ^ 1) * KB) = rk; *(LAS u32x4*)(lds + vdst + (cur ^ 1) * VB) = rv; }
            __syncthreads();
        }
        lsum += __shfl_xor(lsum, 32);
        store_o(o, 1.f / lsum, oC + 64 * head, 512, lane, TokLin{tokq});
    }
}

__device__ __forceinline__ void p_mixnorm(const Args& a) {
    const int tid_ = otid(), lane = tid_ & 63, wave = rfl(tid_ >> 6);
    const bf16_t* oA = (const bf16_t*)(a.ws + WS_OBUF + OB_A); const bf16_t* oC = (const bf16_t*)(a.ws + WS_OBUF + OB_C); const bf16_t* oB = (const bf16_t*)(a.ws + WS_OBUF + OB_B);
    const float* lB = (const float*)(a.ws + WS_LB); bf16_t* mb = (bf16_t*)(a.ws + WS_MB);
    const int gw = blockIdx.x * NWAVES + wave, NGW = gridDim.x * NWAVES;
    for (int row = gw; row < NTOK; row += NGW) {
        f32x4 v[4];
        { const u32x2 w = *(const u32x2*)(oA + (size_t)row * 256 + 4 * lane); v[0] = (f32x4){bflo(w.x), bfhi(w.x), bflo(w.y), bfhi(w.y)}; }
        { f32x4 s = {0.f, 0.f, 0.f, 0.f};
#pragma unroll
          for (int br = 0; br < 3; ++br) { const u32x2 w = *(const u32x2*)(oB + ((size_t)br * NTOK + row) * 256 + 4 * lane); s += (f32x4){bflo(w.x), bfhi(w.x), bflo(w.y), bfhi(w.y)}; }
          const f32x4 lv = *(const f32x4*)(lB + (size_t)row * 16 + 4 * (lane >> 4)); v[1] = s * (1.f / (lv.x + lv.y + lv.z)); }
#pragma unroll
        for (int j = 0; j < 2; ++j) { const u32x2 w = *(const u32x2*)(oC + (size_t)row * 512 + 4 * lane + 256 * j); v[2 + j] = (f32x4){bflo(w.x), bfhi(w.x), bflo(w.y), bfhi(w.y)}; }
        float sa = (v[0].x * v[0].x + v[0].y * v[0].y) + (v[0].z * v[0].z + v[0].w * v[0].w);
        float sb = (v[1].x * v[1].x + v[1].y * v[1].y) + (v[1].z * v[1].z + v[1].w * v[1].w);
        float sc = (v[2].x * v[2].x + v[2].y * v[2].y) + (v[2].z * v[2].z + v[2].w * v[2].w) + (v[3].x * v[3].x + v[3].y * v[3].y) + (v[3].z * v[3].z + v[3].w * v[3].w);
        sa = wave_sum(sa); sb = wave_sum(sb); sc = wave_sum(sc);
        const float ra = 1.f / sqrtf(sa * (1.f / 256.f) + RMS_EPS), rb = 1.f / sqrtf(sb * (1.f / 256.f) + RMS_EPS), rc = 1.f / sqrtf(sc * (1.f / 512.f) + RMS_EPS);
        v[0] = v[0] * ra; v[1] = v[1] * rb; v[2] = v[2] * rc; v[3] = v[3] * rc;
#pragma unroll
        for (int j = 0; j < 4; ++j) { u32x2 o; o.x = pk2(v[j].x, v[j].y); o.y = pk2(v[j].z, v[j].w); *(u32x2*)(mb + (size_t)row * DM + 4 * lane + 256 * j) = o; }
    }
}

constexpr int N_PHASES = 34;
__global__ void __launch_bounds__(NTHR, 2) fwd(Args a) {
    extern __shared__ __attribute__((aligned(16))) unsigned char lds_raw[];
    LAS unsigned char* lds = (LAS unsigned char*)lds_raw;
    const int tid = threadIdx.x;
    unsigned char* ws = a.ws;
    unsigned* ctl = (unsigned*)(ws + WS_CTL);
    const int lo = a.ph_lo, hi = a.ph_hi;
    if (tid < 16) ((LAS unsigned*)(lds + L_BARW))[tid] = 0u;
    __syncthreads();
    XcdBarrier bar; bar.bar = ctl + CW_BAR; bar.x = 0; bar.st = nullptr;
    if (hi - lo > 1) bar = xcd_barrier_post(ctl + CW_BAR, (volatile LAS unsigned*)(lds + L_BARW));
#ifdef PH_ONLY
#define PHSEL(j) ((j) == PH_ONLY)
#else
#define PHSEL(j) true
#endif
#define IN(p) (lo <= (p) && (p) < hi)
#define SEAM(p) do { if ((p) + 1 < hi) xcd_barrier(bar); } while (0)

    if (PHSEL(100) && IN(0)) { p0_prologue(a, lds); SEAM(0); }
    for (int l = 0; l < DEPTH; ++l) {
        const int pb = 1 + 8 * l;
        ws = oq(ws);
        bf16_t* xb = (bf16_t*)(ws + WS_XB); bf16_t* mbuf = (bf16_t*)(ws + WS_MB); bf16_t* qkv = (bf16_t*)(ws + WS_QKV);
        if (PHSEL(0) && IN(pb + 0)) { p_combine(a, l, false, lds); SEAM(pb + 0); }
        if (PHSEL(1) && IN(pb + 1)) {
            DenseSched S{xb, DM, (const bf16_t*)(ws + WS_WIN) + (size_t)l * INC * DM, DM, NTOK / 256, INC / 256, INC};
            EpiQKV E{(const float*)(ws + WS_RSTD1), a.in[I_QKG] + (size_t)l * 384, (const f32x2*)(ws + WS_ROPE), qkv};
            gemm_simple(lds, S, E, DM);
            SEAM(pb + 1);
        }
        if (PHSEL(2) && IN(pb + 2)) { p_attn_a(a, l, lds); p_attn_b(a, l, lds); __syncthreads(); p_attn_c(a, l, lds); SEAM(pb + 2); }
        if (PHSEL(3) && IN(pb + 3)) { p_mixnorm(a); SEAM(pb + 3); }
        if (PHSEL(4) && IN(pb + 4)) {
            DenseSched S{mbuf, DM, (const bf16_t*)(ws + WS_WOUT) + (size_t)l * DM * DM, DM, NTOK / 256, DM / 256, DM};
            EpiWout E{l == 0 ? a.in[I_X] : a.out, a.out, xb, (float*)(ws + WS_SSQP)};
            gemm_simple(lds, S, E, DM);
            SEAM(pb + 4);
        }
        if (PHSEL(5) && IN(pb + 5)) {
            DenseSched S{xb, DM, (const bf16_t*)(ws + WS_WR) + (size_t)l * 64 * DM, DM, NTOK / 256, 1, 36};
            EpiRouter E{(const float*)(ws + WS_SSQP), (float*)(ws + WS_RSTD2), a.in[I_BRG] + l * 4, a.in[I_BRE] + l * 32, ctl + CW_CNT + 64 * l, (int*)(ws + WS_LIST), (float*)(ws + WS_GLIST), (int*)(ws + WS_ASSIGN)};
            gemm_simple(lds, S, E, DM);
            SEAM(pb + 5);
        }
        if (PHSEL(6) && IN(pb + 6)) {
            moe_tables(ctl, l, lds);
            MoeSched S{xb, DM, (const bf16_t*)(ws + WS_WGU) + (size_t)l * NE * DM * DM, (size_t)DM * DM, DM, (const int*)(ws + WS_LIST), (const float*)(ws + WS_GLIST), true};
            EpiGU E{(const float*)(ws + WS_RSTD2), (bf16_t*)(ws + WS_OBUF)};
            gemm_simple(lds, S, E, DM);
            SEAM(pb + 6);
        }
        if (PHSEL(7) && IN(pb + 7)) {
            moe_tables(ctl, l, lds);
            MoeSched S{(const bf16_t*)(ws + WS_OBUF), DE, (const bf16_t*)(ws + WS_WD) + (size_t)l * NE * DM * DE, (size_t)DM * DE, DE, (const int*)(ws + WS_LIST), (const float*)(ws + WS_GLIST), false};
            EpiDown E{qkv};
            gemm_simple(lds, S, E, DE);
            SEAM(pb + 7);
        }
    }
    if (PHSEL(101) && IN(33)) { p_combine(a, DEPTH, true, lds); }
#undef IN
#undef SEAM
}

extern "C" void kernel_launch(void* const* d_in, const int* in_sizes, int n_in, void* d_out, int out_size, void* d_ws, size_t ws_size, hipStream_t stream) {
    static int grid = 0;
    if (grid == 0) {
        if (n_in != 15 || in_sizes[0] != NTOK * DM || out_size != NTOK * DM || ws_size < WS_END) { fprintf(stderr, "kernel_launch: unexpected shapes (n_in %d, in0 %d, out %d, ws %zu)\n", n_in, n_in > 0 ? in_sizes[0] : -1, out_size, ws_size); grid = -1; return; }
        int dev = 0, cus = 0;
        if (hipGetDevice(&dev) != hipSuccess || hipDeviceGetAttribute(&cus, hipDeviceAttributeMultiprocessorCount, dev) != hipSuccess) { grid = -1; return; }
        if (hipFuncSetAttribute((const void*)fwd, hipFuncAttributeMaxDynamicSharedMemorySize, LDS_BYTES) != hipSuccess) { fprintf(stderr, "kernel_launch: hipFuncSetAttribute failed\n"); grid = -1; return; }
        int per_cu = 0;
        if (hipOccupancyMaxActiveBlocksPerMultiprocessor(&per_cu, (const void*)fwd, NTHR, LDS_BYTES) != hipSuccess || per_cu < 1) fprintf(stderr, "kernel_launch: occupancy query reports %d\n", per_cu);
        (void)hipGetLastError();
        grid = cus;
    }
    if (grid < 0) return;
    (void)hipMemsetAsync((char*)d_ws + WS_CTL, 0, CTL_ZERO_BYTES, stream);
    Args a{};
    for (int i = 0; i < 15; ++i) a.in[i] = (const float*)d_in[i];
    a.out = (float*)d_out; a.ws = (unsigned char*)d_ws;
#if MK_ONE_LAUNCH
    a.ph_lo = 0; a.ph_hi = N_PHASES;
    hipLaunchKernelGGL(fwd, dim3(grid), dim3(NTHR), LDS_BYTES, stream, a);
#else
    for (int p = 0; p < N_PHASES; ++p) { a.ph_lo = p; a.ph_hi = p + 1; hipLaunchKernelGGL(fwd, dim3(grid), dim3(NTHR), LDS_BYTES, stream, a); }
#endif
}
```

```cpp
#include <hip/hip_runtime.h>
#include <cstdio>
#include <cstdint>

#ifndef PROBE_PHASE
#define PROBE_PHASE -1
#endif
#ifndef MK_ONE_LAUNCH
#define MK_ONE_LAUNCH 1
#endif

#define LAS __attribute__((address_space(3)))
#define GAS __attribute__((address_space(1)))
typedef unsigned short bf16_t;
typedef short bf16x8 __attribute__((ext_vector_type(8)));
typedef short s16x4 __attribute__((ext_vector_type(4)));
typedef short v4i16_t __attribute__((ext_vector_type(4)));
typedef float f32x2 __attribute__((ext_vector_type(2)));
typedef float f32x4 __attribute__((ext_vector_type(4)));
typedef float f32x16 __attribute__((ext_vector_type(16)));
typedef unsigned u32x2 __attribute__((ext_vector_type(2)));
typedef unsigned u32x4 __attribute__((ext_vector_type(4)));
typedef int i32x4 __attribute__((ext_vector_type(4)));
typedef __bf16 bf16x2_t __attribute__((ext_vector_type(2)));

constexpr int NTOK = 32768, DM = 1024, INC = 2304, NE = 32, DE = 512, DEPTH = 4, SEQ = 4096, BATCH = 8;
constexpr int NWAVES = 8, NTHR = 512;
constexpr float RMS_EPS = 1e-6f;
constexpr float LOG2E = 1.4426950408889634f;
constexpr float C2 = 0.125f * LOG2E;
constexpr int COL_QA = 0, COL_KA = 256, COL_VA = 512, COL_QB = 768, COL_KB = 1024, COL_VB = 1280, COL_QC = 1536, COL_KC = 2048, COL_VC = 2176;

constexpr size_t MiB = 1u << 20;
constexpr size_t WS_CTL = 0, CTL_ZERO_BYTES = 1 * MiB;
constexpr size_t WS_WIN = 2 * MiB;
constexpr size_t WS_WOUT = 20 * MiB;
constexpr size_t WS_WR = 28 * MiB;
constexpr size_t WS_ROPE = 29 * MiB;
constexpr size_t WS_RPBMAX = 29 * MiB + 64 * 1024;
constexpr size_t WS_WGU = 32 * MiB;
constexpr size_t WS_WD = 288 * MiB;
constexpr size_t WS_XB = 416 * MiB;
constexpr size_t WS_MB = 480 * MiB;
constexpr size_t WS_QKV = 544 * MiB;
constexpr size_t WS_OBUF = 688 * MiB;
constexpr size_t WS_LB = 784 * MiB;
constexpr size_t WS_RSTD1 = 786 * MiB;
constexpr size_t WS_RSTD2 = WS_RSTD1 + 256 * 1024;
constexpr size_t WS_SSQP = 787 * MiB;
constexpr size_t WS_LIST = 790 * MiB;
constexpr size_t WS_GLIST = 794 * MiB;
constexpr size_t WS_ASSIGN = 798 * MiB;
constexpr size_t WS_RSLIST = 800 * MiB;
constexpr size_t WS_VT8 = 804 * MiB;
constexpr size_t WS_END = 808 * MiB;
constexpr size_t OB_A = 0, OB_C = (size_t)NTOK * 256 * 2, OB_B = OB_C + (size_t)NTOK * 512 * 2;
constexpr int CW_CNT = 1024;
constexpr int CW_BAR = 4096;

constexpr int LDS_BYTES = 163840;
constexpr int L_SCR = 0;
constexpr int L_MISC = 139264;
constexpr int L_BARW = LDS_BYTES - 64;

__device__ __forceinline__ int rfl(int v) { return __builtin_amdgcn_readfirstlane(v); }
__device__ __forceinline__ int otid(int wv) { unsigned z = 0u; asm volatile("" : "+v"(z)); return wv * 64 + (int)__builtin_amdgcn_mbcnt_hi(~0u, __builtin_amdgcn_mbcnt_lo(~0u, z)); }
template <class T> __device__ __forceinline__ T* oq(T* p) { asm volatile("" : "+s"(p)); return p; }
__device__ __forceinline__ unsigned pk2(float lo, float hi) { f32x2 v = {lo, hi}; bf16x2_t b = __builtin_convertvector(v, bf16x2_t); return __builtin_bit_cast(unsigned, b); }
__device__ __forceinline__ bf16_t f2bf(float f) { return (bf16_t)(pk2(f, 0.f) & 0xffffu); }
__device__ __forceinline__ float bflo(unsigned w) { return __uint_as_float(w << 16); }
__device__ __forceinline__ float bfhi(unsigned w) { return __uint_as_float(w & 0xffff0000u); }
__device__ __forceinline__ float shx(float v, int m, int lane) { return __int_as_float(__builtin_amdgcn_ds_bpermute((lane ^ m) << 2, __float_as_int(v))); }
__device__ __forceinline__ float shl(float v, int src) { return __int_as_float(__builtin_amdgcn_ds_bpermute(src << 2, __float_as_int(v))); }
__device__ __forceinline__ float wave_sum(float v, int lane) {
#pragma unroll
    for (int o = 1; o < 64; o <<= 1) v += shx(v, o, lane);
    return v;
}
__device__ __forceinline__ float wave_max(float v, int lane) {
#pragma unroll
    for (int o = 1; o < 64; o <<= 1) v = fmaxf(v, shx(v, o, lane));
    return v;
}
__device__ __forceinline__ void lds_barrier() { asm volatile("s_waitcnt lgkmcnt(0)\n\ts_barrier" ::: "memory"); }
__device__ __forceinline__ int xcd_vcu() { const int G = gridDim.x, c = blockIdx.x; return (G % 8 == 0) ? (c % 8) * (G / 8) + c / 8 : c; }
__device__ __forceinline__ int v_off(int row, int ch) { return row * 128 + ((ch ^ (((row >> 1) & 1) << 2)) * 16); }
__device__ __forceinline__ int crow(int r, int hi) { return (r & 3) + 8 * (r >> 2) + 4 * hi; }
#define MFMA32(a, b, c) __builtin_amdgcn_mfma_f32_32x32x16_bf16((a), (b), (c), 0, 0, 0)
#define MFMA16(a, b, c) __builtin_amdgcn_mfma_f32_16x16x32_bf16((a), (b), (c), 0, 0, 0)
__device__ __forceinline__ s16x4 vtr(const LAS char* p) { return __builtin_bit_cast(s16x4, __builtin_amdgcn_ds_read_tr16_b64_v4i16((LAS v4i16_t*)p)); }

#define XB_TMO      128
#define XB_XCNT(j)  (256  + 64 * (j))
#define XB_XSUB(j)  (1280 + 64 * (j))
#define XB_XGEN(j)  (2304 + 64 * (j))
#define XB_TOP      3328
#define XB_TOPGEN   3392
#define XCD_BAR_WORDS 3456
#define XB_SPIN_CAP (1u << 18)
__device__ __forceinline__ unsigned xb_ld(unsigned* p)              { return __hip_atomic_load(p, __ATOMIC_RELAXED, __HIP_MEMORY_SCOPE_AGENT); }
__device__ __forceinline__ unsigned xb_add(unsigned* p, unsigned v) { return __hip_atomic_fetch_add(p, v, __ATOMIC_RELAXED, __HIP_MEMORY_SCOPE_AGENT); }
__device__ __forceinline__ unsigned xb_xcc_id() { return (unsigned)__builtin_amdgcn_s_getreg((3 << 11) | 20) & 0xFu; }
#define XB_SPIN(cond, bar) do { unsigned _sp = 0; while (cond) { __builtin_amdgcn_s_sleep(1); \
    if ((++_sp & 255u) == 0u) { if (xb_ld(&(bar)[XB_TMO])) break; if (_sp > XB_SPIN_CAP) { atomicAdd(&(bar)[XB_TMO], 1u); break; } } } } while (0)
struct XcdBarrier { unsigned* bar; unsigned x; volatile LAS unsigned* st; };
__device__ __forceinline__ XcdBarrier xcd_barrier_post(unsigned* bar, volatile LAS unsigned* st, bool t0) {
    XcdBarrier b; b.bar = bar; b.x = xb_xcc_id(); b.st = st;
    if (t0) (void)xb_add(&bar[XB_XCNT(b.x)], 1u);
    return b;
}
__device__ __forceinline__ void xcd_barrier_complete(unsigned* bar, unsigned x, unsigned& nloc, unsigned& nx) {
    const unsigned G = gridDim.x * gridDim.y * gridDim.z;
    unsigned sum, cnt, mine, sp = 0u;
    for (;;) {
        sum = 0u; cnt = 0u; mine = 0u;
#pragma unroll
        for (unsigned j = 0; j < 16; ++j) { const unsigned c = xb_ld(&bar[XB_XCNT(j)]); sum += c; cnt += (c > 0u) ? 1u : 0u; mine = (j == x) ? c : mine; }
        if (sum == G) break;
        __builtin_amdgcn_s_sleep(1);
        if ((++sp & 255u) == 0u) { if (xb_ld(&bar[XB_TMO])) break; if (sp > XB_SPIN_CAP) { atomicAdd(&bar[XB_TMO], 1u); break; } }
    }
    nloc = mine > 0u ? mine : 1u; nx = cnt > 0u ? cnt : 1u;
}
__device__ __forceinline__ void xcd_barrier(const XcdBarrier& b, bool t0) {
    asm volatile("s_waitcnt vmcnt(0)" ::: "memory");
    __syncthreads();
    if (t0) {
        unsigned* bar = b.bar;
        __builtin_amdgcn_s_waitcnt(0);
        unsigned nloc = b.st[0], nx = b.st[1];
        if (nloc == 0u) { xcd_barrier_complete(bar, b.x, nloc, nx); b.st[0] = nloc; b.st[1] = nx; }
        const unsigned old = xb_add(&bar[XB_XSUB(b.x)], 1u);
        const unsigned gen = old / nloc;
        if (old + 1u == (gen + 1u) * nloc) {
            __builtin_amdgcn_fence(__ATOMIC_RELEASE, "agent");
            asm volatile("s_waitcnt vmcnt(0)" ::: "memory");
            const unsigned og = xb_add(&bar[XB_TOP], 1u);
            const unsigned tg = og / nx;
            if (og + 1u == (tg + 1u) * nx) xb_add(&bar[XB_TOPGEN], 1u);
            else XB_SPIN(xb_ld(&bar[XB_TOPGEN]) == tg, bar);
            __builtin_amdgcn_fence(__ATOMIC_ACQUIRE, "agent");
            xb_add(&bar[XB_XGEN(b.x)], 1u);
            asm volatile("s_waitcnt vmcnt(0)" ::: "memory");
        } else {
            XB_SPIN(xb_ld(&bar[XB_XGEN(b.x)]) == gen, bar);
            __builtin_amdgcn_fence(__ATOMIC_ACQUIRE, "agent");
            asm volatile("s_waitcnt vmcnt(0)" ::: "memory");
        }
    }
    __syncthreads();
}

struct Args { const float* in[15]; float* out; unsigned char* ws; int ph_lo, ph_hi, li, pad; };
struct GArgs { const GAS float* in[15]; GAS float* out; GAS unsigned char* ws; int ph_lo, ph_hi, li, pad; };
__device__ __forceinline__ GArgs kargs() {
    GArgs r;
#if defined(__HIP_DEVICE_COMPILE__)
    typedef const __attribute__((address_space(4))) unsigned long long* CU64P;
    CU64P p = (CU64P)__builtin_amdgcn_kernarg_segment_ptr(); asm volatile("" : "+s"(p));
    unsigned long long* d = (unsigned long long*)&r;
#pragma unroll
    for (int i = 0; i < (int)(sizeof(Args) / 8); ++i) d[i] = p[i];
#endif
    return r;
}
enum { I_X = 0, I_N1G, I_WIN, I_QKG, I_RPB, I_MIXG, I_WOUT, I_N2G, I_WRG, I_BRG, I_WRE, I_BRE, I_WG, I_WU, I_WDN };

__device__ __forceinline__ int slot32(int j) { return 16 * ((j >> 2) & 1) + 4 * (j >> 3) + (j & 3); }
__device__ __forceinline__ int destrow(int mode, int c) {
    if (mode == 1) { const int j = c & 31; const bool rope = (c >= COL_QC) && (c < COL_VC);
        return (c & ~255) + ((c >> 5) & 1) * 128 + ((c >> 6) & 3) * 32 + (rope ? j : slot32(j)); }
    if (mode == 2) return 256 * (c >> 7) + (c & 96) + slot32(c & 31);
    if (mode == 3) return 256 * (c >> 7) + 128 + (c & 96) + slot32(c & 31);
    return (c & ~31) + slot32(c & 31);
}
__device__ __forceinline__ void tp_item(const GAS float* W, int K, int N, GAS bf16_t* WT, const GAS float* kscale, int mode, LAS float* scr, int item, int lane) {
    const int nblk = N / 32, kb = item / nblk, nb = item % nblk, k0 = 64 * kb, n0 = 32 * nb;
    float wv_[32];
#pragma unroll
    for (int i = 0; i < 32; ++i) wv_[i] = W[(size_t)(k0 + 2 * i + (lane >> 5)) * N + n0 + (lane & 31)];
#pragma unroll
    for (int i = 0; i < 32; ++i) { const int kk = 2 * i + (lane >> 5); const float s = kscale ? kscale[k0 + kk] : 1.f; scr[kk * 33 + (lane & 31)] = wv_[i] * s; }
    asm volatile("s_waitcnt lgkmcnt(0)" ::: "memory");
    const int c = lane & 7;
#pragma unroll
    for (int j = 0; j < 4; ++j) { const int n = (lane >> 3) + 8 * j; const LAS float* s = scr + (8 * c) * 33 + n;
        u32x4 o; o.x = pk2(s[0 * 33], s[1 * 33]); o.y = pk2(s[2 * 33], s[3 * 33]); o.z = pk2(s[4 * 33], s[5 * 33]); o.w = pk2(s[6 * 33], s[7 * 33]);
        *(GAS u32x4*)(WT + (size_t)destrow(mode, n0 + n) * K + k0 + 8 * c) = o; }
    asm volatile("s_waitcnt lgkmcnt(0)" ::: "memory");
}
__device__ __forceinline__ void p0_prologue(const GArgs& a, LAS unsigned char* lds, int wv) {
    const int tid_ = otid(wv), lane = tid_ & 63, wave = rfl(tid_ >> 6);
    LAS float* scr = (LAS float*)(lds + wave * 16384);
    const int gw = blockIdx.x * NWAVES + wave, NGW = gridDim.x * NWAVES;
    GAS unsigned char* ws = a.ws;
    constexpr int I_IN = 16 * 72, I_OUT = 16 * 32, I_E = 256, PER_L = I_IN + I_OUT + NE * 3 * I_E;
    for (int it = gw; it < DEPTH * PER_L; it += NGW) {
        const int l = it / PER_L; int r = it % PER_L;
        if (r < I_IN) { tp_item(a.in[I_WIN] + (size_t)l * DM * INC, DM, INC, (GAS bf16_t*)(ws + WS_WIN) + (size_t)l * INC * DM, a.in[I_N1G] + l * DM, 1, scr, r, lane); continue; } r -= I_IN;
        if (r < I_OUT) { tp_item(a.in[I_WOUT] + (size_t)l * DM * DM, DM, DM, (GAS bf16_t*)(ws + WS_WOUT) + (size_t)l * DM * DM, a.in[I_MIXG] + l * DM, 0, scr, r, lane); continue; } r -= I_OUT;
        const int e = r / (3 * I_E), rr = r % (3 * I_E), which = rr / I_E, item = rr % I_E; const size_t le = (size_t)l * NE + e;
        if (which == 0)      tp_item(a.in[I_WG] + le * DM * DE, DM, DE, (GAS bf16_t*)(ws + WS_WGU) + le * DM * DM, a.in[I_N2G] + l * DM, 2, scr, item, lane);
        else if (which == 1) tp_item(a.in[I_WU] + le * DM * DE, DM, DE, (GAS bf16_t*)(ws + WS_WGU) + le * DM * DM, a.in[I_N2G] + l * DM, 3, scr, item, lane);
        else                 tp_item(a.in[I_WDN] + le * DE * DM, DE, DM, (GAS bf16_t*)(ws + WS_WD) + le * DM * DE, nullptr, 0, scr, item, lane);
    }
    const int gt = blockIdx.x * NTHR + tid_, NGT = gridDim.x * NTHR;
    for (int idx = gt; idx < DEPTH * 36 * DM; idx += NGT) {
        const int l = idx / (36 * DM), n = (idx / DM) % 36, k = idx % DM;
        const float w = (n < 4) ? a.in[I_WRG][((size_t)l * DM + k) * 4 + n] : a.in[I_WRE][((size_t)l * DM + k) * 32 + (n - 4)];
        ((GAS bf16_t*)(ws + WS_WR))[((size_t)l * 64 + n) * DM + k] = f2bf(w * a.in[I_N2G][l * DM + k]);
    }
    if (wave == 0 && blockIdx.x < DEPTH) { const GAS float* rp = a.in[I_RPB] + (size_t)blockIdx.x * 1860; float mx = 0.f;
        for (int i = lane; i < 1860; i += 64) mx = fmaxf(mx, fabsf(rp[i]));
        mx = wave_max(mx, lane);
        const GAS float* qg = a.in[I_QKG] + (size_t)blockIdx.x * 384;
        const float ba = wave_max(fabsf(qg[lane]), lane) * wave_max(fabsf(qg[64 + lane]), lane), bb_ = wave_max(fabsf(qg[128 + lane]), lane) * wave_max(fabsf(qg[192 + lane]), lane),
                    bc = wave_max(fabsf(qg[256 + lane]), lane) * wave_max(fabsf(qg[320 + lane]), lane);
        const float gqc = qg[256 + lane], gkc = qg[320 + lane]; const float sigc = LOG2E * sqrtf(wave_sum(gqc * gqc * gkc * gkc, lane) * (1.f / 64.f));
        if (lane == 0) { GAS float* mr = (GAS float*)(ws + WS_RPBMAX) + 4 * blockIdx.x; mr[0] = (8.f * ba + mx) * LOG2E; mr[1] = 8.f * bb_ * LOG2E; mr[2] = fminf(9.f * sigc, 1.15f * 8.f * bc * LOG2E) - 8.75f; mr[3] = mx; } }
    if (gt < 64 * 16) {
        const int pos = gt >> 4, f = gt & 15;
        double inv = 1.0; for (int i = 0; i < f; ++i) inv *= 0.56234132519034908;
        const float invf = (float)inv; const float angf = (float)pos * invf;
        const double x = (double)angf;
        const double kq = __builtin_rint(x * 0.63661977236758134);
        const double rr = (x - kq * 1.5707963267341256) - kq * 6.0771005065061922e-11;
        const double r2 = rr * rr;
        double sn = rr * (1.0 + r2 * (-1.0 / 6 + r2 * (1.0 / 120 + r2 * (-1.0 / 5040 + r2 * (1.0 / 362880 + r2 * (-1.0 / 39916800 + r2 * (1.0 / 6227020800.0)))))));
        double cs = 1.0 + r2 * (-0.5 + r2 * (1.0 / 24 + r2 * (-1.0 / 720 + r2 * (1.0 / 40320 + r2 * (-1.0 / 3628800 + r2 * (1.0 / 479001600.0 + r2 * (-1.0 / 87178291200.0)))))));
        const int q = ((int)kq) & 3; double c, s;
        if (q == 0) { c = cs; s = sn; } else if (q == 1) { c = -sn; s = cs; } else if (q == 2) { c = -cs; s = -sn; } else { c = sn; s = -cs; }
        ((GAS f32x2*)(ws + WS_ROPE))[gt] = (f32x2){(float)c, (float)s};
    }
}

constexpr int LM_CNT = L_MISC, LM_TPRE = L_MISC + 128, LM_TOKL = L_MISC + 512, LM_GL = L_MISC + 512 + 1024, LM_RC = L_MISC + 512 + 2048, LM_RB = LM_RC + 128;
__device__ __forceinline__ void moe_tables(const GAS unsigned* ctl, int l, LAS unsigned char* lds, int wv) {
    LAS int* cnt = (LAS int*)(lds + LM_CNT); LAS int* tpre = (LAS int*)(lds + LM_TPRE);
    const int tid = otid(wv);
    __syncthreads();
    if (tid < 32) cnt[tid] = (int)__hip_atomic_load(ctl + CW_CNT + 64 * l + tid, __ATOMIC_RELAXED, __HIP_MEMORY_SCOPE_AGENT);
    __syncthreads();
    if (tid < 64) {
        const int lane = tid; int v = (lane < 32) ? ((cnt[lane & 31] + 255) >> 8) : 0; const int own = v;
#pragma unroll
        for (int o = 1; o < 32; o <<= 1) { const int t = __builtin_amdgcn_ds_bpermute(((lane - o) & 63) << 2, v); if (lane >= o) v += t; }
        if (lane < 32) tpre[lane] = v - own;
        if (lane == 31) tpre[32] = v;
    }
    __syncthreads();
}

__device__ __forceinline__ void p_combine(const GArgs& a, int l, bool final_, LAS unsigned char* lds, int wv) {
    const int tid_ = otid(wv), lane = tid_ & 63, wave = rfl(tid_ >> 6);
    GAS unsigned char* ws = oq(a.ws);
    const bool comb = (l > 0);
    const GAS bf16_t* Y = (const GAS bf16_t*)(ws + WS_QKV);
    const GAS int* assign = (const GAS int*)(ws + WS_ASSIGN);
    GAS bf16_t* xb = (GAS bf16_t*)(ws + WS_XB); GAS float* rstd1 = (GAS float*)(ws + WS_RSTD1);
    if (comb) moe_tables((const GAS unsigned*)(ws + WS_CTL), l - 1, lds, wv);
    const LAS int* tpre = (const LAS int*)(lds + LM_TPRE);
    const int gw = blockIdx.x * NWAVES + wave, NGW = gridDim.x * NWAVES;
    constexpr int RB = 4;
    for (int row0 = gw * RB; row0 < NTOK; row0 += NGW * RB) {
        f32x4 v[RB][4];
        if (!comb) {
#pragma unroll
            for (int q = 0; q < RB; ++q)
#pragma unroll
                for (int j = 0; j < 4; ++j) v[q][j] = *(const GAS f32x4*)(a.in[I_X] + (size_t)(row0 + q) * DM + 4 * lane + 256 * j);
        } else {
            i32x4 as[RB]; u32x2 x0[RB][4], y0[RB][4], y1[RB][4];
#pragma unroll
            for (int q = 0; q < RB; ++q) as[q] = *(const GAS i32x4*)(assign + (row0 + q) * 4);
#pragma unroll
            for (int q = 0; q < RB; ++q)
#pragma unroll
                for (int j = 0; j < 4; ++j) x0[q][j] = *(const GAS u32x2*)(xb + (size_t)(row0 + q) * DM + 4 * lane + 256 * j);
#pragma unroll
            for (int q = 0; q < RB; ++q) { const size_t s0 = (size_t)tpre[as[q].x] * 256 + as[q].y, s1 = (size_t)tpre[as[q].z] * 256 + as[q].w;
#pragma unroll
                for (int j = 0; j < 4; ++j) { y0[q][j] = *(const GAS u32x2*)(Y + s0 * DM + 4 * lane + 256 * j); y1[q][j] = *(const GAS u32x2*)(Y + s1 * DM + 4 * lane + 256 * j); } }
#pragma unroll
            for (int q = 0; q < RB; ++q)
#pragma unroll
                for (int j = 0; j < 4; ++j) {
                    v[q][j].x = bflo(x0[q][j].x) + bflo(y0[q][j].x) + bflo(y1[q][j].x); v[q][j].y = bfhi(x0[q][j].x) + bfhi(y0[q][j].x) + bfhi(y1[q][j].x);
                    v[q][j].z = bflo(x0[q][j].y) + bflo(y0[q][j].y) + bflo(y1[q][j].y); v[q][j].w = bfhi(x0[q][j].y) + bfhi(y0[q][j].y) + bfhi(y1[q][j].y); }
        }
#pragma unroll
        for (int q = 0; q < RB; ++q) {
            const int row = row0 + q;
            if (final_) {
#pragma unroll
                for (int j = 0; j < 4; ++j) *(GAS f32x4*)(a.out + (size_t)row * DM + 4 * lane + 256 * j) = v[q][j];
            } else {
                float s = 0.f;
#pragma unroll
                for (int j = 0; j < 4; ++j) s += (v[q][j].x * v[q][j].x + v[q][j].y * v[q][j].y) + (v[q][j].z * v[q][j].z + v[q][j].w * v[q][j].w);
                s = wave_sum(s, lane);
                if (lane == 0) rstd1[row] = 1.f / sqrtf(s * (1.f / DM) + RMS_EPS);
#pragma unroll
                for (int j = 0; j < 4; ++j) { u32x2 o; o.x = pk2(v[q][j].x, v[q][j].y); o.y = pk2(v[q][j].z, v[q][j].w); *(GAS u32x2*)(xb + (size_t)row * DM + 4 * lane + 256 * j) = o; }
            }
        }
    }
}

struct GUnit { int pm, pn, e, T, rbase, nai, ord; };
constexpr int G_AS = 0, G_BS = 20480, G_ROWB = 80;
template <class Sched, class Epi>
__device__ __forceinline__ void gemm_simple(LAS unsigned char* lds, const Sched& S, const Epi& E, const int K, int wv) {
    const int tid = otid(wv), wid = rfl(tid >> 6), lane = tid & 63, wr = wid >> 2, wc = wid & 3, fr = lane & 15, fq = lane >> 4;
    GUnit u;
    for (int ui = 0; S.next(ui, u, lds); ++ui) {
        S.begin(u, lds);
        const GAS bf16_t* ap[2]; const GAS bf16_t* bp[2]; bool bv[2];
        const int nbv = S.b_valid(u);
#pragma unroll
        for (int i = 0; i < 2; ++i) { const int r = (tid >> 2) + 128 * i; ap[i] = S.a_row(u, r, lds) + (tid & 3) * 8; bp[i] = S.b_row(u, r) + (tid & 3) * 8; bv[i] = r < nbv; }
        f32x4 acc[2][2][4][2];
#pragma unroll
        for (int x = 0; x < 2; ++x)
#pragma unroll
            for (int y = 0; y < 2; ++y)
#pragma unroll
                for (int m = 0; m < 4; ++m)
#pragma unroll
                    for (int n = 0; n < 2; ++n) acc[x][y][m][n] = (f32x4){0.f, 0.f, 0.f, 0.f};
        for (int kt = 0; kt < K / 32; ++kt) {
            u32x4 ra[2], rb[2];
#pragma unroll
            for (int i = 0; i < 2; ++i) { ra[i] = *(const GAS u32x4*)(ap[i] + kt * 32); rb[i] = bv[i] ? *(const GAS u32x4*)(bp[i] + kt * 32) : (u32x4){0u, 0u, 0u, 0u}; }
            __syncthreads();
#pragma unroll
            for (int i = 0; i < 2; ++i) { const int r = (tid >> 2) + 128 * i;
                *(LAS u32x4*)(lds + G_AS + r * G_ROWB + (tid & 3) * 16) = ra[i];
                *(LAS u32x4*)(lds + G_BS + r * G_ROWB + (tid & 3) * 16) = rb[i]; }
            __syncthreads();
#pragma unroll
            for (int ai = 0; ai < 2; ++ai) {
                bf16x8 At[4];
#pragma unroll
                for (int m = 0; m < 4; ++m) At[m] = *(const LAS bf16x8*)(lds + G_AS + (128 * ai + 64 * wr + 16 * m + fr) * G_ROWB + 16 * fq);
#pragma unroll
                for (int bj = 0; bj < 2; ++bj) {
                    bf16x8 Bt[2];
#pragma unroll
                    for (int n = 0; n < 2; ++n) Bt[n] = *(const LAS bf16x8*)(lds + G_BS + (128 * bj + 32 * wc + 16 * n + fr) * G_ROWB + 16 * fq);
#pragma unroll
                    for (int m = 0; m < 4; ++m)
#pragma unroll
                        for (int n = 0; n < 2; ++n) acc[ai][bj][m][n] = MFMA16(Bt[n], At[m], acc[ai][bj][m][n]);
                }
            }
        }
        E(acc, u, lds, wid, lane);
    }
}

namespace fg {
constexpr int BK = 64, HALF = 128, HTB = HALF * BK * 2;
__device__ __forceinline__ int lds_byte(int r, int c) { const int st = (r >> 4) * 2 + (c >> 5), rr = r & 15, cc = c & 31, ob = rr * 64 + cc * 2; return st * 1024 + (ob ^ (((ob >> 9) & 1) << 5)); }
__device__ __forceinline__ void stage_rc(int b, int& R, int& C) { const int st = b / 1024, sb = b % 1024, swz = sb ^ (((sb >> 9) & 1) << 5); R = (st >> 1) * 16 + swz / 64; C = (st & 1) * 32 + (swz % 64) / 2; }
}
template <class Sched, class Epi>
__device__ __forceinline__ void gemm_fast(LAS unsigned char* lds, const Sched& S, const Epi& E, const int K, int wv) {
    using namespace fg;
    const int tid = otid(wv), wid = rfl(tid >> 6), lane = tid & 63, wr = wid >> 2, wc = wid & 3, fr = lane & 15, fq = lane >> 4;
    const int nt = K / BK;
    unsigned voffB[2];
#pragma unroll
    for (int i = 0; i < 2; ++i) { int R_, C_; stage_rc(tid * 16 + i * 8192, R_, C_); voffB[i] = (unsigned)(R_ * K + C_) * 2u; }
    const size_t kstep = (size_t)(BK * 2), hstep = (size_t)HALF * K * 2;
    const unsigned ldsw = (unsigned)wid * 1024u;
    const int aoff = lds_byte(wr * 64 + fr, fq * 8), boff = lds_byte(wc * 32 + fr, fq * 8);
#define FG_SA(b, h) (((b) * 2 + (h)) * HTB)
#define FG_SB(b, h) ((4 + (b) * 2 + (h)) * HTB)
#define FG_STAGE(bufoff, gbase, voff) do { _Pragma("unroll") for (int _i = 0; _i < 2; ++_i) \
        __builtin_amdgcn_global_load_lds((const GAS unsigned*)((const GAS char*)(gbase) + (voff)[_i]), (LAS unsigned*)(lds + (bufoff) + ldsw + _i * 8192), 16, 0, 0); } while (0)
#define FG_LDA(dst, b, h) do { _Pragma("unroll") for (int m = 0; m < 4; ++m) _Pragma("unroll") for (int k = 0; k < 2; ++k) dst[m][k] = *(const LAS bf16x8*)(lds + FG_SA(b, h) + aoff + m * 2048 + k * 1024); } while (0)
#define FG_LDB(dst, b, h) do { _Pragma("unroll") for (int n = 0; n < 2; ++n) _Pragma("unroll") for (int k = 0; k < 2; ++k) dst[n][k] = *(const LAS bf16x8*)(lds + FG_SB(b, h) + boff + n * 2048 + k * 1024); } while (0)
#define FG_MMA(ai, bj, At, Bt) do { __builtin_amdgcn_s_setprio(1); _Pragma("unroll") for (int m = 0; m < 4; ++m) _Pragma("unroll") for (int n = 0; n < 2; ++n) _Pragma("unroll") for (int k = 0; k < 2; ++k) \
        acc[ai][bj][m][n] = MFMA16(Bt[n][k], At[m][k], acc[ai][bj][m][n]); __builtin_amdgcn_s_setprio(0); } while (0)
#define FG_WAIT_V(n) asm volatile("s_waitcnt vmcnt(" #n ")" ::: "memory")
#define FG_WAIT_L(n) asm volatile("s_waitcnt lgkmcnt(" #n ")" ::: "memory")
#define FG_BAR __builtin_amdgcn_s_barrier()
#define FG_SCHED __builtin_amdgcn_sched_barrier(0)
    GUnit cur, nxt; int ui = 0;
    if (!S.next(0, cur, lds)) return;
    f32x4 acc[2][2][4][2];
#pragma unroll
    for (int x = 0; x < 2; ++x)
#pragma unroll
        for (int y = 0; y < 2; ++y)
#pragma unroll
            for (int m = 0; m < 4; ++m)
#pragma unroll
                for (int n = 0; n < 2; ++n) acc[x][y][m][n] = (f32x4){0.f, 0.f, 0.f, 0.f};
    bf16x8 At[4][2], B0[2][2], B1[2][2];
    const GAS char* Ab = (const GAS char*)S.a_base();
    unsigned vc[2][2];
    S.a_off(cur, lds, tid, vc);
    const GAS char* cB = (const GAS char*)S.b_ptr(cur);
    FG_STAGE(FG_SB(0, 0), cB, voffB); FG_STAGE(FG_SB(0, 1), cB + hstep, voffB); FG_STAGE(FG_SA(0, 0), Ab, vc[0]); FG_STAGE(FG_SA(0, 1), Ab, vc[1]);
    if (wr == 1) FG_BAR;
    FG_WAIT_V(2); FG_BAR;
    FG_STAGE(FG_SB(1, 0), cB + kstep, voffB); FG_STAGE(FG_SA(1, 0), Ab + kstep, vc[0]); FG_STAGE(FG_SB(1, 1), cB + hstep + kstep, voffB);
    FG_WAIT_V(6); FG_BAR;
    for (;;) {
        const bool has_next = S.next(ui + 1, nxt, lds);
        const GAS char* nB = has_next ? (const GAS char*)S.b_ptr(nxt) : cB;
        const bool full = cur.nai == 2;
        for (int t = 0; t < nt; t += 2) {
            const bool last = (t == nt - 2);
            const GAS char* a1 = Ab + (size_t)(t + 1) * kstep;
            const GAS char* a2 = last ? Ab : Ab + (size_t)(t + 2) * kstep; const GAS char* b2 = last ? nB : cB + (size_t)(t + 2) * kstep;
            const GAS char* a3 = a2 + kstep; const GAS char* b3 = b2 + kstep;
            const unsigned va1[2] = {vc[1][0], vc[1][1]};
            if (last && has_next) S.a_off(nxt, lds, tid, vc);
            FG_LDB(B0, 0, 0); FG_LDB(B1, 0, 1); FG_SCHED; FG_LDA(At, 0, 0); FG_STAGE(FG_SA(1, 1), a1, va1);
            FG_WAIT_V(8); FG_WAIT_L(0); FG_BAR; FG_MMA(0, 0, At, B0); FG_MMA(0, 1, At, B1); FG_BAR; FG_SCHED;
            FG_LDA(At, 0, 1); FG_STAGE(FG_SB(0, 0), b2, voffB); FG_STAGE(FG_SB(0, 1), b2 + hstep, voffB); FG_STAGE(FG_SA(0, 0), a2, vc[0]);
            FG_WAIT_V(8); FG_WAIT_L(0); FG_BAR; if (full) { FG_MMA(1, 0, At, B0); FG_MMA(1, 1, At, B1); } FG_BAR; FG_SCHED;
            FG_LDB(B0, 1, 0); FG_LDB(B1, 1, 1); FG_SCHED; FG_LDA(At, 1, 0); FG_STAGE(FG_SA(0, 1), a2, vc[1]);
            FG_WAIT_V(8); FG_WAIT_L(0); FG_BAR; FG_MMA(0, 0, At, B0); FG_MMA(0, 1, At, B1); FG_BAR; FG_SCHED;
            FG_LDA(At, 1, 1); FG_STAGE(FG_SB(1, 0), b3, voffB); FG_STAGE(FG_SB(1, 1), b3 + hstep, voffB); FG_STAGE(FG_SA(1, 0), a3, vc[0]);
            FG_WAIT_V(8); FG_WAIT_L(0); FG_BAR; if (full) { FG_MMA(1, 0, At, B0); FG_MMA(1, 1, At, B1); } FG_BAR; FG_SCHED;
        }
        if (wr == 0) FG_BAR;
        E(acc, cur, lds, wid, lane);
        if (!has_next) break;
#pragma unroll
        for (int x = 0; x < 2; ++x)
#pragma unroll
            for (int y = 0; y < 2; ++y)
#pragma unroll
                for (int m = 0; m < 4; ++m)
#pragma unroll
                    for (int n = 0; n < 2; ++n) acc[x][y][m][n] = (f32x4){0.f, 0.f, 0.f, 0.f};
        cur = nxt; cB = nB; ++ui;
        if (wr == 1) FG_BAR;
    }
    FG_WAIT_V(0);
    FG_BAR;
#undef FG_SA
#undef FG_SB
#undef FG_STAGE
#undef FG_LDA
#undef FG_LDB
#undef FG_MMA
#undef FG_WAIT_V
#undef FG_WAIT_L
#undef FG_BAR
#undef FG_SCHED
}
struct FDense {
    const GAS bf16_t* A; const GAS bf16_t* Bt; int K, nM, nN;
    __device__ __forceinline__ bool next(int i, GUnit& u, LAS unsigned char*) const {
        const int nwg = nM * nN, G = (int)gridDim.x, nfull = (nwg / G) * G; const int L = i * G + (int)blockIdx.x;
        int wgid = L; u.rbase = 0; u.nai = 2; u.ord = i;
        if (L >= nfull) { const int r = L - nfull; wgid = nfull + (r >> 1); if (wgid >= nwg) return false; u.rbase = 128 * (r & 1); u.nai = 1; }
        { const int q = nwg / 8, r = nwg % 8, xcd = wgid % 8, off = wgid / 8; wgid = (xcd < r ? xcd * (q + 1) : r * (q + 1) + (xcd - r) * q) + off; }
        const int nig = 8 * nN, gid = wgid / nig, fm = gid * 8, gsz = (nM - fm) < 8 ? (nM - fm) : 8;
        u.pm = fm + ((wgid % nig) % gsz); u.pn = (wgid % nig) / gsz; u.e = 0; u.T = 0; return true;
    }
    __device__ __forceinline__ const GAS bf16_t* a_base() const { return A; }
    __device__ __forceinline__ void a_off(const GUnit& u, LAS unsigned char*, int tid, unsigned (&off)[2][2]) const {
#pragma unroll
        for (int i = 0; i < 2; ++i) { int R, C; fg::stage_rc(tid * 16 + i * 8192, R, C);
#pragma unroll
            for (int h = 0; h < 2; ++h) off[h][i] = (unsigned)((256 * u.pm + u.rbase + (u.nai == 2 ? 128 * h : 0) + R) * K + C) * 2u; }
    }
    __device__ __forceinline__ const GAS bf16_t* b_ptr(const GUnit& u) const { return Bt + (size_t)256 * u.pn * K; }
};
constexpr int LM_FT = L_MISC + 512;
constexpr int LM_UT = L_MISC + 512 + 5120;
struct FMoe {
    const GAS bf16_t* A; const GAS bf16_t* Bt; size_t bstride; int K; bool gather;
    __device__ __forceinline__ static int vcu() { const int G = gridDim.x, c = blockIdx.x; return (G % 8 == 0) ? (c % 8) * (G / 8) + c / 8 : c; }
    __device__ __forceinline__ bool next(int i, GUnit& u, LAS unsigned char* lds) const {
        if (i >= 6) return false;
        const i32x4 r = *(const LAS i32x4*)(lds + LM_UT + 16 * i);
        u.e = rfl(r.x); u.T = rfl(r.y); u.pm = rfl(r.z); const int w = rfl(r.w); u.pn = w & 3; u.nai = (w & 4) ? 1 : 2; u.rbase = (w & 8) ? 128 : 0; u.ord = i; return u.e >= 0;
    }
    __device__ __forceinline__ const GAS bf16_t* a_base() const { return A; }
    __device__ __forceinline__ void a_off(const GUnit& u, LAS unsigned char* lds, int tid, unsigned (&off)[2][2]) const {
        const LAS int* ft = (const LAS int*)(lds + LM_FT) + 256 * u.ord;
#pragma unroll
        for (int i = 0; i < 2; ++i) { int R, C; fg::stage_rc(tid * 16 + i * 8192, R, C);
#pragma unroll
            for (int h = 0; h < 2; ++h) { const int rl = u.rbase + (u.nai == 2 ? 128 * h : 0) + R; const int row = gather ? ft[rl] : (256 * u.T + rl); off[h][i] = (unsigned)(row * K + C) * 2u; } }
    }
    __device__ __forceinline__ const GAS bf16_t* b_ptr(const GUnit& u) const { return Bt + (size_t)u.e * bstride + (size_t)256 * u.pn * K; }
};
__device__ __forceinline__ void moe_units(const GAS int* list, bool fill_tok, LAS unsigned char* lds, int wv) {
    const int tid = otid(wv); const LAS int* cnt = (const LAS int*)(lds + LM_CNT); const LAS int* tpre = (const LAS int*)(lds + LM_TPRE);
    LAS int* ft = (LAS int*)(lds + LM_FT); LAS i32x4* ut = (LAS i32x4*)(lds + LM_UT);
    if (tid < 8) {
        const int G = (int)gridDim.x, total = 4 * tpre[32], nfull = (total / G) * G, L = tid * G + FMoe::vcu(); i32x4 r = {-1, 0, 0, 0};
        int idx = L, hb = 0;
        if (L >= nfull) { const int q = L - nfull; idx = nfull + (q >> 1); hb = 4 | ((q & 1) << 3); }
        if (idx < total) { const int T = idx >> 2; int e = 0;
#pragma unroll 8
            for (int k = 1; k < 32; ++k) e += (tpre[k] <= T) ? 1 : 0;
            r = (i32x4){e, T, T - tpre[e], (idx & 3) | hb}; }
        ut[tid] = r;
    }
    __syncthreads();
    if (fill_tok && tid < 256) {
        int tk[5];
#pragma unroll
        for (int i = 0; i < 5; ++i) { const i32x4 r = ut[i]; const int e = r.x < 0 ? 0 : r.x; const int idx = 256 * r.z + tid; tk[i] = (r.x >= 0 && idx < cnt[e]) ? list[e * NTOK + idx] : 0; }
#pragma unroll
        for (int i = 0; i < 5; ++i) ft[256 * i + tid] = tk[i];
    }
    __syncthreads();
}

struct DenseSched {
    const GAS bf16_t* A; int lda; const GAS bf16_t* Bt; int ldb; int nM, nN, nvalid;
    __device__ __forceinline__ bool next(int i, GUnit& u, LAS unsigned char*) const { const int L = i * (int)gridDim.x + (int)blockIdx.x; if (L >= nM * nN) return false; u.pm = L / nN; u.pn = L % nN; u.e = 0; u.T = 0; u.rbase = 0; u.nai = 2; u.ord = i; return true; }
    __device__ __forceinline__ void begin(const GUnit&, LAS unsigned char*) const {}
    __device__ __forceinline__ const GAS bf16_t* a_row(const GUnit& u, int r, LAS unsigned char*) const { return A + (size_t)(256 * u.pm + r) * lda; }
    __device__ __forceinline__ const GAS bf16_t* b_row(const GUnit& u, int r) const { return Bt + (size_t)(256 * u.pn + r) * ldb; }
    __device__ __forceinline__ int b_valid(const GUnit& u) const { return nvalid - 256 * u.pn; }
};
struct EpiQKV {
    const GAS float* rstd1; const GAS float* qkg  ; const GAS f32x2* rope; GAS bf16_t* qkv; GAS unsigned char* vt8;
    __device__ __forceinline__ void operator()(const f32x4 (&acc)[2][2][4][2], const GUnit& u, LAS unsigned char* lds, int wid, int lane) const {
        const int wr = wid >> 2, wc = wid & 3, fr = lane & 15, fq = lane >> 4;
        const int colbase = 256 * u.pn + 64 * wc;
        int mixer = -1, qk = 0;
        if (colbase < COL_KA) { mixer = 0; qk = 0; } else if (colbase < COL_VA) { mixer = 0; qk = 1; } else if (colbase < COL_QB) { mixer = -1; }
        else if (colbase < COL_KB) { mixer = 1; qk = 0; } else if (colbase < COL_VB) { mixer = 1; qk = 1; } else if (colbase < COL_QC) { mixer = -1; }
        else if (colbase < COL_KC) { mixer = 2; qk = 0; } else if (colbase < COL_VC) { mixer = 2; qk = 1; } else { mixer = -1; }
        f32x4 g[2][2];
        if (mixer >= 0) {
#pragma unroll
            for (int bj = 0; bj < 2; ++bj)
#pragma unroll
                for (int n = 0; n < 2; ++n) g[bj][n] = *(const GAS f32x4*)(qkg + (mixer * 2 + qk) * 64 + 32 * bj + (mixer == 2 ? 16 * n + 4 * fq : 8 * fq + 4 * n));
        }
        float rsv[2][4];
#pragma unroll
        for (int ai = 0; ai < 2; ++ai)
#pragma unroll
            for (int m = 0; m < 4; ++m) rsv[ai][m] = rstd1[256 * u.pm + u.rbase + (ai < u.nai ? 128 * ai : 0) + 64 * wr + 16 * m + fr];
        const LAS f32x2* ropeL = (const LAS f32x2*)(lds + L_MISC);
#pragma unroll
        for (int ai = 0; ai < 2; ++ai) {
            if (ai >= u.nai) continue;
            float ssv[4];
            if (mixer >= 0) {
#pragma unroll
                for (int m = 0; m < 4; ++m) { float ss = 0.f;
#pragma unroll
                    for (int bj = 0; bj < 2; ++bj)
#pragma unroll
                        for (int n = 0; n < 2; ++n) { const f32x4 t = acc[ai][bj][m][n]; ss += (t.x * t.x + t.y * t.y) + (t.z * t.z + t.w * t.w); }
                    ssv[m] = ss * rsv[ai][m] * rsv[ai][m]; }
#pragma unroll
                for (int m = 0; m < 4; ++m) ssv[m] += shx(ssv[m], 16, lane);
#pragma unroll
                for (int m = 0; m < 4; ++m) ssv[m] += shx(ssv[m], 32, lane);
            }
#pragma unroll
            for (int m = 0; m < 4; ++m) {
                const int row = 256 * u.pm + u.rbase + 128 * ai + 64 * wr + 16 * m + fr;
                float rs = rsv[ai][m];
                if (mixer >= 0) rs *= __builtin_amdgcn_rsqf(ssv[m] * (1.f / 64.f) + RMS_EPS) * (qk == 0 ? C2 : 1.f);
                f32x4 v[2][2];
#pragma unroll
                for (int bj = 0; bj < 2; ++bj)
#pragma unroll
                    for (int n = 0; n < 2; ++n) v[bj][n] = acc[ai][bj][m][n] * rs;
                if (mixer >= 0) {
#pragma unroll
                    for (int bj = 0; bj < 2; ++bj)
#pragma unroll
                        for (int n = 0; n < 2; ++n) v[bj][n] = v[bj][n] * g[bj][n];
                    if (mixer == 2) {
                        const int t = row & (SEQ - 1);
#pragma unroll
                        for (int bj = 0; bj < 2; ++bj) {
                            const int pos = (bj == 0) ? (t >> 6) : (t & 63);
#pragma unroll
                            for (int i = 0; i < 4; ++i) { const f32x2 cs = ropeL[pos * 16 + 4 * fq + i]; const float x1 = v[bj][0][i], x2 = v[bj][1][i];
                                v[bj][0][i] = x1 * cs.x - x2 * cs.y; v[bj][1][i] = x2 * cs.x + x1 * cs.y; }
                        }
                    }
                }
                if (mixer == 2) {
#pragma unroll
                    for (int bj = 0; bj < 2; ++bj)
#pragma unroll
                        for (int n = 0; n < 2; ++n) { int w = __builtin_amdgcn_cvt_pk_fp8_f32(v[bj][n].x, v[bj][n].y, 0, false); w = __builtin_amdgcn_cvt_pk_fp8_f32(v[bj][n].z, v[bj][n].w, w, true);
                            *(GAS int*)((GAS unsigned char*)qkv + (unsigned)((row * INC + COL_QC) * 2 + (colbase - COL_QC) + 32 * bj + 16 * n + 4 * fq)) = w; }
                } else if (colbase >= COL_VC) {
                    const int tokn = row & (SEQ - 1), key = tokn & 63, pos = ((key & 4) << 3) | ((key & 32) >> 1) | ((key & 24) >> 1) | (key & 3);
                    const unsigned vbase = (unsigned)((((row >> 12) * 2 + ((colbase - COL_VC) >> 6)) * 64) * SEQ + (tokn & ~63) + pos);
#pragma unroll
                    for (int bj = 0; bj < 2; ++bj)
#pragma unroll
                        for (int n = 0; n < 2; ++n) { int w = __builtin_amdgcn_cvt_pk_fp8_f32(v[bj][n].x, v[bj][n].y, 0, false); w = __builtin_amdgcn_cvt_pk_fp8_f32(v[bj][n].z, v[bj][n].w, w, true);
#pragma unroll
                            for (int i = 0; i < 4; ++i) vt8[vbase + (unsigned)((32 * bj + 8 * fq + 4 * n + i) * SEQ)] = (unsigned char)((unsigned)w >> (8 * i)); }
                } else {
#pragma unroll
                    for (int bj = 0; bj < 2; ++bj) { u32x4 o; o.x = pk2(v[bj][0].x, v[bj][0].y); o.y = pk2(v[bj][0].z, v[bj][0].w); o.z = pk2(v[bj][1].x, v[bj][1].y); o.w = pk2(v[bj][1].z, v[bj][1].w);
                        *(GAS u32x4*)(qkv + (unsigned)(row * INC + colbase + 32 * bj + 8 * fq)) = o; }
                }
            }
        }
    }
};
struct EpiWout {
    GAS bf16_t* xb; GAS float* ssqp;
    __device__ __forceinline__ void operator()(const f32x4 (&acc)[2][2][4][2], const GUnit& u, LAS unsigned char*, int wid, int lane) const {
        const int wr = wid >> 2, wc = wid & 3, fr = lane & 15, fq = lane >> 4;
        float ssv[2][4] = {{0.f, 0.f, 0.f, 0.f}, {0.f, 0.f, 0.f, 0.f}};
        u32x4 bx[2][4][2];
#pragma unroll
        for (int ai = 0; ai < 2; ++ai)
#pragma unroll
            for (int m = 0; m < 4; ++m)
#pragma unroll
                for (int bj = 0; bj < 2; ++bj) { const int row = 256 * u.pm + u.rbase + (ai < u.nai ? 128 * ai : 0) + 64 * wr + 16 * m + fr;
                    bx[ai][m][bj] = *(const GAS u32x4*)(xb + (unsigned)(row * DM + 256 * u.pn + 128 * bj + 32 * wc + 8 * fq)); }
#pragma unroll
        for (int ai = 0; ai < 2; ++ai)
#pragma unroll
            for (int m = 0; m < 4; ++m) {
                if (ai >= u.nai) continue;
                const int row = 256 * u.pm + u.rbase + 128 * ai + 64 * wr + 16 * m + fr; float ss = 0.f;
#pragma unroll
                for (int bj = 0; bj < 2; ++bj) { const unsigned off = (unsigned)(row * DM + 256 * u.pn + 128 * bj + 32 * wc + 8 * fq);
                    const u32x4 b = bx[ai][m][bj];
                    const f32x4 x0 = (f32x4){bflo(b.x), bfhi(b.x), bflo(b.y), bfhi(b.y)} + acc[ai][bj][m][0], x1 = (f32x4){bflo(b.z), bfhi(b.z), bflo(b.w), bfhi(b.w)} + acc[ai][bj][m][1];
                    u32x4 o; o.x = pk2(x0.x, x0.y); o.y = pk2(x0.z, x0.w); o.z = pk2(x1.x, x1.y); o.w = pk2(x1.z, x1.w); *(GAS u32x4*)(xb + off) = o;
                    ss += (x0.x * x0.x + x0.y * x0.y) + (x0.z * x0.z + x0.w * x0.w) + (x1.x * x1.x + x1.y * x1.y) + (x1.z * x1.z + x1.w * x1.w); }
                ssv[ai][m] = ss;
            }
#pragma unroll
        for (int ai = 0; ai < 2; ++ai)
#pragma unroll
            for (int m = 0; m < 4; ++m) ssv[ai][m] += shx(ssv[ai][m], 16, lane);
#pragma unroll
        for (int ai = 0; ai < 2; ++ai)
#pragma unroll
            for (int m = 0; m < 4; ++m) ssv[ai][m] += shx(ssv[ai][m], 32, lane);
#pragma unroll
        for (int ai = 0; ai < 2; ++ai)
#pragma unroll
            for (int m = 0; m < 4; ++m) { const int row = 256 * u.pm + u.rbase + 128 * ai + 64 * wr + 16 * m + fr; if (ai < u.nai && fq == 0) ssqp[(unsigned)(row * 16 + 4 * u.pn + wc)] = ssv[ai][m]; }
    }
};
__device__ __forceinline__ void p_router(const GArgs& a, int l, LAS unsigned char* lds, int wv) {
    const int tid = otid(wv), lane = tid & 63, wave = rfl(tid >> 6), fr = lane & 15, fq = lane >> 4;
    constexpr int WS_ = 2064, L_W = 0, L_LG = 48 * WS_  ;
    GAS unsigned char* ws = a.ws;
    const GAS bf16_t* xb = (const GAS bf16_t*)(ws + WS_XB); const GAS bf16_t* Wr = (const GAS bf16_t*)(ws + WS_WR) + (size_t)l * 64 * DM;
    const GAS float* ssqp = (const GAS float*)(ws + WS_SSQP); GAS float* rstd2 = (GAS float*)(ws + WS_RSTD2);
    const GAS float* brg = a.in[I_BRG] + l * 4; const GAS float* bre = a.in[I_BRE] + l * 32;
    GAS unsigned* cntg = (GAS unsigned*)(ws + WS_CTL) + CW_CNT + 64 * l;
    GAS int* list = (GAS int*)(ws + WS_LIST); GAS float* glist = (GAS float*)(ws + WS_GLIST); GAS float* rslist = (GAS float*)(ws + WS_RSLIST); GAS int* assign = (GAS int*)(ws + WS_ASSIGN);
    LAS float* lg = (LAS float*)(lds + L_LG); LAS int* rc = (LAS int*)(lds + LM_RC); LAS int* rb = (LAS int*)(lds + LM_RB);
    __syncthreads();
    { u32x4 wv_[12];
#pragma unroll
      for (int i = 0; i < 12; ++i) { const int idx = tid + NTHR * i, row = idx >> 7, ch = idx & 127; const int rc_ = row < 36 ? row : 35;
          wv_[i] = *(const GAS u32x4*)(Wr + (size_t)rc_ * DM + 8 * ch); }
#pragma unroll
      for (int i = 0; i < 12; ++i) { const int idx = tid + NTHR * i, row = idx >> 7, ch = idx & 127; const u32x4 z = {0u, 0u, 0u, 0u};
          *(LAS u32x4*)(lds + L_W + row * WS_ + ch * 16) = row < 36 ? wv_[i] : z; } }
    __syncthreads();
    for (int unit = blockIdx.x; unit < NTOK / 128; unit += gridDim.x) {
        const int row0 = 128 * unit + 16 * wave;
        bf16x8 af[32];
#pragma unroll
        for (int kk = 0; kk < 32; ++kk) af[kk] = *(const GAS bf16x8*)(xb + (size_t)(row0 + fr) * DM + 32 * kk + 8 * fq);
        f32x4 acc[3];
#pragma unroll
        for (int n = 0; n < 3; ++n) acc[n] = (f32x4){0.f, 0.f, 0.f, 0.f};
#pragma unroll
        for (int kk = 0; kk < 32; ++kk)
#pragma unroll
            for (int n = 0; n < 3; ++n) { const bf16x8 bfr = *(const LAS bf16x8*)(lds + L_W + (16 * n + fr) * WS_ + (32 * kk + 8 * fq) * 2); acc[n] = MFMA16(bfr, af[kk], acc[n]); }
#pragma unroll
        for (int n = 0; n < 3; ++n)
#pragma unroll
            for (int i = 0; i < 4; ++i) { const int c = 16 * n + 4 * fq + i; if (c < 36) lg[(16 * wave + fr) * 40 + c] = acc[n][i]; }
        if (tid < 32) rc[tid] = 0;
        __syncthreads();
        int e0 = 0, e1 = 0, r0 = 0, r1 = 0; float g0 = 0.f, g1 = 0.f, rsv = 0.f; const int row = 128 * unit + tid;
        if (tid < 128) {
            float ss = 0.f;
#pragma unroll
            for (int j = 0; j < 4; ++j) { const f32x4 p = *(const GAS f32x4*)(ssqp + (size_t)row * 16 + 4 * j); ss += (p.x + p.y) + (p.z + p.w); }
            const float rs = 1.f / sqrtf(ss * (1.f / DM) + RMS_EPS); rstd2[row] = rs; rsv = rs;
            float gl[4]; int grp = 0;
#pragma unroll
            for (int j = 0; j < 4; ++j) gl[j] = lg[tid * 40 + j] * rs + brg[j];
            float gm = gl[0];
#pragma unroll
            for (int j = 1; j < 4; ++j) if (gl[j] > gm) { gm = gl[j]; grp = j; }
            float den = 0.f;
#pragma unroll
            for (int j = 0; j < 4; ++j) den += __expf(gl[j] - gm);
            const float pgrp = 1.f / den;
            float el[8];
#pragma unroll
            for (int j = 0; j < 8; ++j) el[j] = lg[tid * 40 + 4 + 8 * grp + j] * rs + bre[8 * grp + j];
            int i0 = 0; float v0 = el[0];
#pragma unroll
            for (int j = 1; j < 8; ++j) if (el[j] > v0) { v0 = el[j]; i0 = j; }
            int i1 = -1; float v1 = 0.f;
#pragma unroll
            for (int j = 0; j < 8; ++j) if (j != i0 && (i1 < 0 || el[j] > v1)) { v1 = el[j]; i1 = j; }
            const float ex = __expf(v1 - v0); const float w0 = 1.f / (1.f + ex);
            g0 = pgrp * w0; g1 = pgrp * (ex * w0);
            e0 = 8 * grp + i0; e1 = 8 * grp + i1;
            r0 = __hip_atomic_fetch_add(rc + e0, 1, __ATOMIC_RELAXED, __HIP_MEMORY_SCOPE_WORKGROUP);
            r1 = __hip_atomic_fetch_add(rc + e1, 1, __ATOMIC_RELAXED, __HIP_MEMORY_SCOPE_WORKGROUP);
        }
        __syncthreads();
        if (tid < 32) { const int c = rc[tid]; rb[tid] = c ? (int)__hip_atomic_fetch_add(cntg + tid, (unsigned)c, __ATOMIC_RELAXED, __HIP_MEMORY_SCOPE_AGENT) : 0; }
        __syncthreads();
        if (tid < 128) {
            r0 += rb[e0]; r1 += rb[e1];
            list[e0 * NTOK + r0] = row; glist[e0 * NTOK + r0] = g0; rslist[e0 * NTOK + r0] = rsv;
            list[e1 * NTOK + r1] = row; glist[e1 * NTOK + r1] = g1; rslist[e1 * NTOK + r1] = rsv;
            *(GAS i32x4*)(assign + row * 4) = (i32x4){e0, r0, e1, r1};
        }
        __syncthreads();
    }
}
struct EpiGU {
    const GAS float* rslist; GAS bf16_t* H;
    __device__ __forceinline__ void operator()(const f32x4 (&acc)[2][2][4][2], const GUnit& u, LAS unsigned char* lds, int wid, int lane) const {
        const int wr = wid >> 2, wc = wid & 3, fr = lane & 15, fq = lane >> 4;
        float rsv[2][4];
#pragma unroll
        for (int ai = 0; ai < 2; ++ai)
#pragma unroll
            for (int m = 0; m < 4; ++m) rsv[ai][m] = rslist[(unsigned)(u.e * NTOK + 256 * u.pm + u.rbase + (ai < u.nai ? 128 * ai : 0) + 64 * wr + 16 * m + fr)];
#pragma unroll
        for (int ai = 0; ai < 2; ++ai)
#pragma unroll
            for (int m = 0; m < 4; ++m) {
                if (ai >= u.nai) continue;
                const int rl = u.rbase + 128 * ai + 64 * wr + 16 * m + fr; const float rs = rsv[ai][m];
                f32x4 h[2];
#pragma unroll
                for (int n = 0; n < 2; ++n) { const f32x4 g = acc[ai][0][m][n] * rs, up = acc[ai][1][m][n] * rs;
#pragma unroll
                    for (int i = 0; i < 4; ++i) h[n][i] = g[i] * __builtin_amdgcn_rcpf(1.f + __expf(-g[i])) * up[i]; }
                u32x4 o; o.x = pk2(h[0].x, h[0].y); o.y = pk2(h[0].z, h[0].w); o.z = pk2(h[1].x, h[1].y); o.w = pk2(h[1].z, h[1].w);
                *(GAS u32x4*)(H + (unsigned)((256 * u.T + rl) * DE + 128 * u.pn + 32 * wc + 8 * fq)) = o;
            }
    }
};
struct EpiDown {
    const GAS float* glist; GAS bf16_t* Y;
    __device__ __forceinline__ void operator()(const f32x4 (&acc)[2][2][4][2], const GUnit& u, LAS unsigned char* lds, int wid, int lane) const {
        const int wr = wid >> 2, wc = wid & 3, fr = lane & 15, fq = lane >> 4;
        float gtv[2][4];
#pragma unroll
        for (int ai = 0; ai < 2; ++ai)
#pragma unroll
            for (int m = 0; m < 4; ++m) gtv[ai][m] = glist[(unsigned)(u.e * NTOK + 256 * u.pm + u.rbase + (ai < u.nai ? 128 * ai : 0) + 64 * wr + 16 * m + fr)];
#pragma unroll
        for (int ai = 0; ai < 2; ++ai)
#pragma unroll
            for (int m = 0; m < 4; ++m) {
                if (ai >= u.nai) continue;
                const int rl = u.rbase + 128 * ai + 64 * wr + 16 * m + fr; const float gt = gtv[ai][m];
#pragma unroll
                for (int bj = 0; bj < 2; ++bj) { const f32x4 y0 = acc[ai][bj][m][0] * gt, y1 = acc[ai][bj][m][1] * gt;
                    u32x4 o; o.x = pk2(y0.x, y0.y); o.y = pk2(y0.z, y0.w); o.z = pk2(y1.x, y1.y); o.w = pk2(y1.z, y1.w);
                    *(GAS u32x4*)(Y + (unsigned)((256 * u.T + rl) * DM + 256 * u.pn + 128 * bj + 32 * wc + 8 * fq)) = o; }
            }
    }
};

template <int KS, int VS, class MaskF>
__device__ __forceinline__ void attn_tile32(const bf16x8 (&qf)[4], const LAS char* Kt, const LAS char* Vt, f32x16 (&o)[2], float& lsum, int lane, const MaskF& mf) {
    const int r32 = lane & 31, hi = lane >> 5;
    f32x16 s; float bb[16];
#pragma unroll
    for (int r = 0; r < 16; ++r) { s[r] = 0.f; bb[r] = mf.bias(r, crow(r, hi)); }
#pragma unroll
    for (int d0 = 0; d0 < 4; ++d0) { const bf16x8 kf = *(const LAS bf16x8*)(Kt + r32 * KS + (16 * d0 + 8 * hi) * 2); s = MFMA32(kf, qf[d0], s); }
    float ps = 0.f;
#pragma unroll
    for (int r = 0; r < 16; ++r) { const float p = __builtin_amdgcn_exp2f(s[r] + bb[r]); s[r] = p; ps += p; }
    lsum += ps;
    u32x4 pw0, pw1;
    pw0.x = pk2(s[0], s[1]); pw0.y = pk2(s[2], s[3]); pw0.z = pk2(s[4], s[5]); pw0.w = pk2(s[6], s[7]);
    pw1.x = pk2(s[8], s[9]); pw1.y = pk2(s[10], s[11]); pw1.z = pk2(s[12], s[13]); pw1.w = pk2(s[14], s[15]);
    const LAS char* vb = Vt + (4 * hi + ((lane & 15) >> 2)) * VS + ((lane >> 4) & 1) * 32 + (lane & 3) * 8;
    const int vsw = (((lane & 15) >> 3) & 1) * 64;
    const LAS char* vb0 = vb + vsw; const LAS char* vb1 = vb + (64 ^ vsw);
#pragma unroll
    for (int d0 = 0; d0 < 2; ++d0) {
#pragma unroll
        for (int st = 0; st < 2; ++st) {
            const LAS char* vbd = d0 ? vb1 : vb0; const s16x4 lo = vtr(vbd + (16 * st) * VS), h4 = vtr(vbd + (16 * st + 8) * VS);
            const bf16x8 vf = {lo[0], lo[1], lo[2], lo[3], h4[0], h4[1], h4[2], h4[3]};
            o[d0] = MFMA32(__builtin_bit_cast(bf16x8, st == 0 ? pw0 : pw1), vf, o[d0]);
        }
    }
}
#define SBAR() __builtin_amdgcn_sched_barrier(0)
template <bool HAS_NEXT, bool HAS_PRE, int KS, int VS, class MaskF>
__device__ __forceinline__ void attn_m_step(f32x16& Sc, f32x16& Sn, const bf16x8 (&qf)[4], bf16x8 (&kf)[4], const LAS char* Kpre, const LAS char* Vc, f32x16 (&o)[2], float& lsum, int lane, const MaskF& mf, bool pre_rt = true) {
    const int r32 = lane & 31, hi = lane >> 5;
    float bb[16]; s16x4 vlo[2][2], vhi[2][2];
#pragma unroll
    for (int r = 0; r < 16; ++r) bb[r] = mf.bias(r, crow(r, hi));
    const LAS char* vb = Vc + (4 * hi + ((lane & 15) >> 2)) * VS + ((lane >> 4) & 1) * 32 + (lane & 3) * 8;
    const int vsw = (((lane & 15) >> 3) & 1) * 64;
    const LAS char* vb0 = vb + vsw; const LAS char* vb1 = vb + (64 ^ vsw);
#pragma unroll
    for (int d0 = 0; d0 < 2; ++d0)
#pragma unroll
        for (int st = 0; st < 2; ++st) { const LAS char* vbd = d0 ? vb1 : vb0; vlo[d0][st] = vtr(vbd + (16 * st) * VS); vhi[d0][st] = vtr(vbd + (16 * st + 8) * VS); }
    if (HAS_NEXT) {
#pragma unroll
        for (int r = 0; r < 16; ++r) Sn[r] = 0.f;
    }
    SBAR();
    float ps = 0.f;
#pragma unroll
    for (int g = 0; g < 4; ++g) {
        if (HAS_NEXT) Sn = MFMA32(kf[g], qf[g], Sn);
#pragma unroll
        for (int i = 0; i < 4; ++i) { Sc[4 * g + i] = __builtin_amdgcn_exp2f(Sc[4 * g + i] + bb[4 * g + i]); ps += Sc[4 * g + i]; }
        SBAR();
    }
    lsum += ps;
    if (HAS_PRE && pre_rt) {
#pragma unroll
        for (int d0 = 0; d0 < 4; ++d0) kf[d0] = *(const LAS bf16x8*)(Kpre + r32 * KS + (16 * d0 + 8 * hi) * 2);
    }
    u32x4 pw0, pw1;
    pw0.x = pk2(Sc[0], Sc[1]); pw0.y = pk2(Sc[2], Sc[3]); pw0.z = pk2(Sc[4], Sc[5]); pw0.w = pk2(Sc[6], Sc[7]);
    pw1.x = pk2(Sc[8], Sc[9]); pw1.y = pk2(Sc[10], Sc[11]); pw1.z = pk2(Sc[12], Sc[13]); pw1.w = pk2(Sc[14], Sc[15]);
#pragma unroll
    for (int d0 = 0; d0 < 2; ++d0)
#pragma unroll
        for (int st = 0; st < 2; ++st) {
            const bf16x8 vf = {vlo[d0][st][0], vlo[d0][st][1], vlo[d0][st][2], vlo[d0][st][3], vhi[d0][st][0], vhi[d0][st][1], vhi[d0][st][2], vhi[d0][st][3]};
            o[d0] = MFMA32(__builtin_bit_cast(bf16x8, st == 0 ? pw0 : pw1), vf, o[d0]);
        }
}
template <int KS>
__device__ __forceinline__ void attn_qk_head(f32x16& S, const bf16x8 (&qf)[4], const LAS char* Kt, int lane) {
    const int r32 = lane & 31, hi = lane >> 5;
#pragma unroll
    for (int r = 0; r < 16; ++r) S[r] = 0.f;
#pragma unroll
    for (int d0 = 0; d0 < 4; ++d0) { const bf16x8 k0 = *(const LAS bf16x8*)(Kt + r32 * KS + (16 * d0 + 8 * hi) * 2); S = MFMA32(k0, qf[d0], S); }
}
template <int KS>
__device__ __forceinline__ void attn_kf_load(bf16x8 (&kf)[4], const LAS char* Kt, int lane) {
    const int r32 = lane & 31, hi = lane >> 5;
#pragma unroll
    for (int d0 = 0; d0 < 4; ++d0) kf[d0] = *(const LAS bf16x8*)(Kt + r32 * KS + (16 * d0 + 8 * hi) * 2);
}
struct TokLin { size_t base; __device__ __forceinline__ size_t operator()(int q) const { return base + q; } };
struct TokDil { size_t base; int dil; __device__ __forceinline__ size_t operator()(int q) const { return base + (size_t)dil * q; } };
template <class TokF>
__device__ __forceinline__ void store_o(const f32x16 (&o)[2], float sc, GAS bf16_t* dst, int ld, int lane, const TokF& tokf) {
    const int r32 = lane & 31, hi = lane >> 5;
#pragma unroll
    for (int r = 0; r < 16; ++r) { const int q = crow(r, hi); const float f = shl(sc, q); const size_t off = (size_t)tokf(q) * ld + r32;
        dst[off] = f2bf(o[0][r] * f); dst[off + 32] = f2bf(o[1][r] * f); }
}
__device__ __forceinline__ float gain_bound(const GAS float* g  , int lane) { return wave_max(fabsf(g[lane]), lane) * wave_max(fabsf(g[64 + lane]), lane); }

struct MaskA { const LAS float* tp; int vb;
    __device__ __forceinline__ float bias(int r, int) const { const int c = (r & 3) + 8 * (r >> 2); return ((unsigned)(vb + c) < 16u) ? tp[c] : -INFINITY; } };
__device__ __forceinline__ void p_attn_a(const GArgs& a, int l, LAS unsigned char* lds, int wv) {
    const int tid = otid(wv), lane = tid & 63, wave = rfl(tid >> 6);
    constexpr int KS = 144, VS = 128, L_K = 0, L_V = 512 * KS, L_OACC = L_V + 512 * VS  , L_LACC = L_OACC + 16384, L_TAB = L_LACC + 256;
    static_assert(L_TAB + 7440 <= L_BARW, "LDS map (attention A)");
    const GAS bf16_t* qkv = (const GAS bf16_t*)(a.ws + WS_QKV); GAS bf16_t* oA = (GAS bf16_t*)(a.ws + WS_OBUF + OB_A);
    const GAS float* rpb = a.in[I_RPB] + (size_t)l * 4 * 15 * 31;
    LAS float* tab = (LAS float*)(lds + L_TAB); LAS float* oacc = (LAS float*)(lds + L_OACC); LAS float* lacc = (LAS float*)(lds + L_LACC);
    const int r32 = lane & 31, hi = lane >> 5;
    __syncthreads();
    const float mref = ((const GAS float*)(a.ws + WS_RPBMAX))[4 * l + 0];
    for (int i = tid; i < 1860; i += NTHR) tab[i] = rpb[i] * LOG2E - mref;
    const int qh = wave & 1, kp = wave >> 1;
    const int qc = 32 * qh + r32; int cs = qc - 8; cs = cs < 0 ? 0 : (cs > 48 ? 48 : cs);
    for (int unit = xcd_vcu(); unit < BATCH * 4 * 8; unit += gridDim.x) {
        const int b = unit >> 5, h = (unit >> 3) & 3, rb = unit & 7;
        const size_t tokb = (size_t)b * SEQ;
        const int rfirst = 8 * rb; int r0 = rfirst - 4; r0 = r0 < 0 ? 0 : (r0 > 56 ? 56 : r0);
        lds_barrier();
        { u32x4 kv[8], vv[8];
#pragma unroll
          for (int i = 0; i < 8; ++i) { const int row = 64 * i + (tid >> 3), ch = tid & 7; const size_t tok = tokb + (size_t)(r0 + (row >> 6)) * 64 + (row & 63);
              kv[i] = *(const GAS u32x4*)(qkv + tok * INC + COL_KA + 64 * h + 8 * ch); vv[i] = *(const GAS u32x4*)(qkv + tok * INC + COL_VA + 64 * h + 8 * ch); }
          asm volatile("" : "+v"(kv[0]), "+v"(kv[1]), "+v"(kv[2]), "+v"(kv[3]), "+v"(kv[4]), "+v"(kv[5]), "+v"(kv[6]), "+v"(kv[7]));
          asm volatile("" : "+v"(vv[0]), "+v"(vv[1]), "+v"(vv[2]), "+v"(vv[3]), "+v"(vv[4]), "+v"(vv[5]), "+v"(vv[6]), "+v"(vv[7]));
#pragma unroll
          for (int i = 0; i < 8; ++i) { const int row = 64 * i + (tid >> 3), ch = tid & 7; const int kr = r0 + (row >> 6), slot = kr & 7, kc = row & 63;
              *(LAS u32x4*)(lds + L_K + (slot * 64 + kc) * KS + ch * 16) = kv[i]; *(LAS u32x4*)(lds + L_V + v_off(slot * 64 + kc, ch)) = vv[i]; } }
        bf16x8 qf[4];
#pragma unroll
        for (int d0 = 0; d0 < 4; ++d0) qf[d0] = *(const GAS bf16x8*)(qkv + (tokb + (size_t)rfirst * 64 + 32 * qh + r32) * INC + COL_QA + 64 * h + 16 * d0 + 8 * hi);
        asm volatile("" : "+v"(qf[0]), "+v"(qf[1]), "+v"(qf[2]), "+v"(qf[3]));
#pragma unroll 1
        for (int rr = 0; rr < 8; ++rr) {
            const int r = rfirst + rr;
            int r0n = r + 1 - 4; r0n = r0n < 0 ? 0 : (r0n > 56 ? 56 : r0n);
            const bool slide = (rr < 7) && (r0n > r0);
            lds_barrier();
            u32x4 nk = {0u, 0u, 0u, 0u}, nv = {0u, 0u, 0u, 0u}; bf16x8 qn[4];
            if (slide) { const size_t tok = tokb + (size_t)(r0n + 7) * 64 + (tid >> 3);
                nk = *(const GAS u32x4*)(qkv + tok * INC + COL_KA + 64 * h + 8 * (tid & 7)); nv = *(const GAS u32x4*)(qkv + tok * INC + COL_VA + 64 * h + 8 * (tid & 7)); }
            if (rr < 7) {
#pragma unroll
                for (int d0 = 0; d0 < 4; ++d0) qn[d0] = *(const GAS bf16x8*)(qkv + (tokb + (size_t)(r + 1) * 64 + 32 * qh + r32) * INC + COL_QA + 64 * h + 16 * d0 + 8 * hi);
            }
            f32x16 o[2]; float lsum = 0.f;
#pragma unroll
            for (int r_ = 0; r_ < 16; ++r_) { o[0][r_] = 0.f; o[1][r_] = 0.f; }
            { const int kr0 = r0 + 2 * kp, s0 = kr0 & 7, s1 = (kr0 + 1) & 7;
              const LAS char* K0 = (const LAS char*)(lds + L_K + (s0 * 64) * KS); const LAS char* K1 = (const LAS char*)(lds + L_K + (s1 * 64) * KS);
              const LAS char* V0 = (const LAS char*)(lds + L_V + (s0 * 64) * VS); const LAS char* V1 = (const LAS char*)(lds + L_V + (s1 * 64) * VS);
              const LAS float* t0 = tab + h * 465 + (kr0 - r + 7) * 31 + (4 * hi + 15 - qc); const LAS float* t1 = t0 + 31;
              f32x16 SA, SB; bf16x8 kf[4];
              attn_qk_head<KS>(SA, qf, K0, lane); attn_kf_load<KS>(kf, K0 + 32 * KS, lane);
              { MaskA mf{t0, 4 * hi - cs};      attn_m_step<true, true, KS, VS>(SA, SB, qf, kf, K1, V0, o, lsum, lane, mf); }
              { MaskA mf{t0 + 32, 32 + 4 * hi - cs}; attn_m_step<true, true, KS, VS>(SB, SA, qf, kf, K1 + 32 * KS, V0 + 32 * VS, o, lsum, lane, mf); }
              { MaskA mf{t1, 4 * hi - cs};      attn_m_step<true, false, KS, VS>(SA, SB, qf, kf, K1, V1, o, lsum, lane, mf); }
              { MaskA mf{t1 + 32, 32 + 4 * hi - cs}; attn_m_step<false, false, KS, VS>(SB, SA, qf, kf, K1, V1 + 32 * VS, o, lsum, lane, mf); } }
#pragma unroll 1
            for (int k = 0; k < 4; ++k) {
                if (kp == k) {
                    if (k == 0) {
#pragma unroll
                        for (int r_ = 0; r_ < 16; ++r_) { LAS float* p = oacc + (32 * qh + crow(r_, hi)) * 64 + r32; p[0] = o[0][r_]; p[32] = o[1][r_]; }
                        lsum += shx(lsum, 32, lane);
                        if (hi == 0) lacc[32 * qh + r32] = lsum;
                    } else {
                        float t0[16], t1[16];
#pragma unroll
                        for (int r_ = 0; r_ < 16; ++r_) { const LAS float* p = oacc + (32 * qh + crow(r_, hi)) * 64 + r32; t0[r_] = p[0]; t1[r_] = p[32]; }
                        const float lprev = lacc[32 * qh + r32];
                        lsum += shx(lsum, 32, lane);
                        asm volatile("s_waitcnt lgkmcnt(0)" ::: "memory");
#pragma unroll
                        for (int r_ = 0; r_ < 16; ++r_) { LAS float* p = oacc + (32 * qh + crow(r_, hi)) * 64 + r32; p[0] = t0[r_] + o[0][r_]; p[32] = t1[r_] + o[1][r_]; }
                        if (hi == 0) lacc[32 * qh + r32] = lprev + lsum;
                    }
                }
                lds_barrier();
            }
            asm volatile("" : "+v"(nk), "+v"(nv));
            if (rr < 7) asm volatile("" : "+v"(qn[0]), "+v"(qn[1]), "+v"(qn[2]), "+v"(qn[3]));
            { const int q = tid >> 3, d8 = (tid & 7) * 8; const LAS float* p = oacc + q * 64 + d8;
              const f32x4 v0 = *(const LAS f32x4*)p, v1 = *(const LAS f32x4*)(p + 4); const float inv = 1.f / lacc[q];
              u32x4 w; w.x = pk2(v0.x * inv, v0.y * inv); w.y = pk2(v0.z * inv, v0.w * inv); w.z = pk2(v1.x * inv, v1.y * inv); w.w = pk2(v1.z * inv, v1.w * inv);
              *(GAS u32x4*)(oA + (tokb + (size_t)r * 64 + q) * 256 + 64 * h + d8) = w; }
            if (slide) { const int slot = (r0n + 7) & 7, kc = tid >> 3;
                *(LAS u32x4*)(lds + L_K + (slot * 64 + kc) * KS + (tid & 7) * 16) = nk; *(LAS u32x4*)(lds + L_V + v_off(slot * 64 + kc, tid & 7)) = nv; }
            if (rr < 7) {
#pragma unroll
                for (int d0 = 0; d0 < 4; ++d0) qf[d0] = qn[d0];
            }
            r0 = r0n;
        }
    }
    lds_barrier();
}

struct MaskB { float dlf, slope2, mref; bool chk, rng; int ukey0, L;
    __device__ __forceinline__ float bias(int r, int key) const {
        const float x = dlf + (float)((r & 3) + 8 * (r >> 2)); float b = fmaf(-slope2, fabsf(x), -mref);
        if (chk) b = (fabsf(x) <= 64.f) ? b : -INFINITY;
        if (rng) b = ((unsigned)(ukey0 + key) < (unsigned)L) ? b : -INFINITY;
        return b; } };
struct BUnit { int h, br, dil, L, rho, u0; size_t tokb; };
__device__ __forceinline__ BUnit b_unit(int unit) {
    if (gridDim.x == 256) unit = 192 * ((unit & 255) >> 5) + (unit & 31) + 32 * (unit >> 8);
    BUnit u; const int b = unit / 192, rem = unit % 192, w48 = rem % 48, sub = w48 & 15; u.h = rem / 48; u.br = w48 >> 4;
    u.dil = (u.br == 0) ? 1 : (u.br == 1 ? 4 : 16); u.L = SEQ / u.dil; u.rho = sub % u.dil; u.u0 = 256 * (sub / u.dil); u.tokb = (size_t)b * SEQ; return u;
}
__device__ __forceinline__ void p_attn_b(const GArgs& a, int l, LAS unsigned char* lds, int wv) {
    const int tid = otid(wv), lane = tid & 63, wave = rfl(tid >> 6);
    constexpr int KS = 144, VS = 128, NK = 384, L_K = 0, L_V = NK * KS, L_STG = L_V + NK * VS, NU = BATCH * 4 * 48;
    const GAS bf16_t* qkv = (const GAS bf16_t*)(a.ws + WS_QKV); GAS bf16_t* oB = (GAS bf16_t*)(a.ws + WS_OBUF + OB_B); GAS float* lB = (GAS float*)(a.ws + WS_LB);
    const int r32 = lane & 31, hi = lane >> 5;
    const float mref = ((const GAS float*)(a.ws + WS_RPBMAX))[4 * l + 1];
    u32x4 kv[6], vv[6];
#define B_LOAD(U) do { _Pragma("unroll") for (int i = 0; i < 6; ++i) { const int idx = tid + NTHR * i, row = idx >> 3, ch = idx & 7; const int up = (U).u0 - 64 + row; const int upc = up < 0 ? 0 : (up >= (U).L ? (U).L - 1 : up); \
            const size_t tok = (U).tokb + (size_t)(U).dil * upc + (U).rho; kv[i] = *(const GAS u32x4*)(qkv + tok * INC + COL_KB + 64 * (U).h + 8 * ch); vv[i] = *(const GAS u32x4*)(qkv + tok * INC + COL_VB + 64 * (U).h + 8 * ch); } \
        } while (0)
    int unit = xcd_vcu();
    if (unit < NU) { const BUnit u = b_unit(unit); B_LOAD(u); }
#pragma unroll 1
    for (; unit < NU; unit += gridDim.x) {
        const BUnit u = b_unit(unit);
        const int dil = u.dil, L = u.L, rho = u.rho, u0 = u.u0, h = u.h, br = u.br; const size_t tokb = u.tokb;
        bf16x8 qf[4];
#pragma unroll
        for (int d0 = 0; d0 < 4; ++d0) qf[d0] = *(const GAS bf16x8*)(qkv + (tokb + (size_t)dil * (u0 + 32 * wave + r32) + rho) * INC + COL_QB + 64 * h + 16 * d0 + 8 * hi);
        lds_barrier();
#pragma unroll
        for (int i = 0; i < 6; ++i) { const int idx = tid + NTHR * i, row = idx >> 3, ch = idx & 7; const int up = u0 - 64 + row; const bool ok = (up >= 0) && (up < L);
            const u32x4 z = {0u, 0u, 0u, 0u};
            *(LAS u32x4*)(lds + L_K + row * KS + ch * 16) = ok ? kv[i] : z; *(LAS u32x4*)(lds + L_V + v_off(row, ch)) = ok ? vv[i] : z; }
        asm volatile("" : "+v"(qf[0]), "+v"(qf[1]), "+v"(qf[2]), "+v"(qf[3]));
        lds_barrier();
        if (unit + (int)gridDim.x < NU) { const BUnit un = b_unit(unit + (int)gridDim.x); B_LOAD(un); }
        const int uq = u0 + 32 * wave;
        f32x16 o[2]; float lsum = 0.f;
#pragma unroll
        for (int r_ = 0; r_ < 16; ++r_) { o[0][r_] = 0.f; o[1][r_] = 0.f; }
        const float slope2 = exp2f(-2.f * (float)(h + 1)) * (float)dil * LOG2E;
        { const LAS char* Kw = (const LAS char*)(lds + L_K + 32 * wave * KS); const LAS char* Vw = (const LAS char*)(lds + L_V + 32 * wave * VS);
          const float dl0 = (float)(4 * hi - r32 - 64); const int uk = uq - 64;
          f32x16 SA, SB; bf16x8 kf[4];
          attn_qk_head<KS>(SA, qf, Kw, lane); attn_kf_load<KS>(kf, Kw + 32 * KS, lane);
#define MB(j, chk) MaskB{dl0 + 32.f * (float)(j), slope2, mref, chk, (uk + 32 * (j) < 0) || (uk + 32 * (j) + 31 >= L), uk + 32 * (j), L}
#pragma unroll 1
          for (int jj = 0; jj < 4; jj += 2) {
              { MaskB mf = MB(jj, jj == 0);      attn_m_step<true, true, KS, VS>(SA, SB, qf, kf, Kw + (jj + 2) * 32 * KS, Vw + jj * 32 * VS, o, lsum, lane, mf); }
              { MaskB mf = MB(jj + 1, false);    attn_m_step<true, true, KS, VS>(SB, SA, qf, kf, Kw + (jj + 3) * 32 * KS, Vw + (jj + 1) * 32 * VS, o, lsum, lane, mf, jj == 0); }
          }
          { MaskB mf = MB(4, true);  attn_m_step<false, false, KS, VS>(SA, SB, qf, kf, Kw, Vw + 128 * VS, o, lsum, lane, mf); }
#undef MB
        }
        lsum += shx(lsum, 32, lane);
        {
          LAS bf16_t* stg = (LAS bf16_t*)(lds + L_STG + wave * 4096);
#pragma unroll
          for (int r_ = 0; r_ < 16; ++r_) { const int q = crow(r_, hi); stg[q * 64 + r32] = f2bf(o[0][r_]); stg[q * 64 + 32 + r32] = f2bf(o[1][r_]); }
          asm volatile("s_waitcnt lgkmcnt(0)" ::: "memory");
          GAS bf16_t* ob = oB + (size_t)br * NTOK * 256 + 64 * h;
#pragma unroll
          for (int j = 0; j < 4; ++j) { const int c = lane + 64 * j, q = c >> 3, d8 = (c & 7) * 8; const u32x4 v = *(const LAS u32x4*)(stg + q * 64 + d8);
              *(GAS u32x4*)(ob + (tokb + (size_t)dil * (uq + q) + rho) * 256 + d8) = v; } }
        if (hi == 0) lB[(tokb + (size_t)dil * (uq + r32) + rho) * 16 + 4 * h + br] = lsum;
    }
#undef B_LOAD
}

typedef int i32x8 __attribute__((ext_vector_type(8)));
#define MFMA8(a_, b_, c_) __builtin_amdgcn_mfma_scale_f32_32x32x64_f8f6f4(a_, b_, c_, 0, 0, 0, 0x7F7F7F7F, 0, 0x7F7F7F7F)
constexpr int KS8 = 80;
__device__ __forceinline__ i32x8 kf8_load(const LAS char* Kt, int lane) {
    const int r32 = lane & 31, hi = lane >> 5;
    const i32x4 lo = *(const LAS i32x4*)(Kt + r32 * KS8 + 32 * hi), h4 = *(const LAS i32x4*)(Kt + r32 * KS8 + 32 * hi + 16);
    return (i32x8){lo.x, lo.y, lo.z, lo.w, h4.x, h4.y, h4.z, h4.w};
}
constexpr int VS8 = 144;
__device__ __forceinline__ i32x8 vf8_load(const LAS char* Vt, int lane) {
    const int r32 = lane & 31, hi = lane >> 5;
    const i32x4 lo = *(const LAS i32x4*)(Vt + r32 * VS8 + 32 * hi), h4 = *(const LAS i32x4*)(Vt + r32 * VS8 + 32 * hi + 16);
    return (i32x8){lo.x, lo.y, lo.z, lo.w, h4.x, h4.y, h4.z, h4.w};
}
__device__ __forceinline__ void attn_c_exp(f32x16& Sc, f32x16& lacc, int& p0, int& p1, int& p2, int& p3) {
#pragma unroll
    for (int g = 0; g < 4; ++g) {
#pragma unroll
        for (int i = 0; i < 4; ++i) Sc[4 * g + i] = __builtin_amdgcn_exp2f(Sc[4 * g + i]);
        lacc[0] += Sc[4 * g]; lacc[1] += Sc[4 * g + 1]; lacc[2] += Sc[4 * g + 2]; lacc[3] += Sc[4 * g + 3];
    }
#define PK8(g_) __builtin_amdgcn_cvt_pk_fp8_f32(Sc[4 * (g_) + 2], Sc[4 * (g_) + 3], __builtin_amdgcn_cvt_pk_fp8_f32(Sc[4 * (g_)], Sc[4 * (g_) + 1], 0, false), true)
    p0 = PK8(0); p1 = PK8(1); p2 = PK8(2); p3 = PK8(3);
#undef PK8
}
template <bool NEXT>
__device__ __forceinline__ void attn_c_pair(f32x16& SA, f32x16& SB, const i32x8& qf, i32x8& kf, const LAS char* K2, const LAS char* K3, const LAS char* Vg, f32x16 (&o)[2], f32x16& lacc, const f32x16& negv, int lane) {
    const i32x8 v0 = vf8_load(Vg, lane), v1 = vf8_load(Vg + 32 * VS8, lane);
    SBAR();
    SB = MFMA8(kf, qf, negv);
    int p0, p1, p2, p3, p4, p5, p6, p7;
    attn_c_exp(SA, lacc, p0, p1, p2, p3);
    if (NEXT) kf = kf8_load(K2, lane);
    SBAR();
    if (NEXT) SA = MFMA8(kf, qf, negv);
    attn_c_exp(SB, lacc, p4, p5, p6, p7);
    if (NEXT) kf = kf8_load(K3, lane);
    SBAR();
    const i32x8 pw = {p0, p1, p2, p3, p4, p5, p6, p7};
    o[0] = MFMA8(pw, v0, o[0]); o[1] = MFMA8(pw, v1, o[1]);
}
__device__ __forceinline__ void p_attn_c(const GArgs& a, int l, LAS unsigned char* lds, int wv) {
    const int tid = otid(wv), lane = tid & 63, wave = rfl(tid >> 6);
    constexpr int TK = 128, KB = TK * KS8, VB = 64 * VS8, L_K = 0, L_V = 3 * KB, L_STG = L_V + 3 * VB, NT = SEQ / TK, ROWB = INC * 2, QC8 = COL_QC * 2;
    static_assert(L_STG + 8 * 4096 <= L_BARW, "LDS map (attention C)");
    const GAS unsigned char* qkv8 = (const GAS unsigned char*)(a.ws + WS_QKV); const GAS unsigned char* vt8 = (const GAS unsigned char*)(a.ws + WS_VT8);
    const int r32 = lane & 31, hi = lane >> 5;
    const float negm = -((const GAS float*)(a.ws + WS_RPBMAX))[4 * l + 2];
    f32x16 negv;
#pragma unroll
    for (int r_ = 0; r_ < 16; ++r_) negv[r_] = negm;
    if (wave >= 4) __builtin_amdgcn_s_setprio(1);
    const int kdst = L_K + (tid >> 2) * KS8 + (tid & 3) * 16, vdst = L_V + (tid >> 3) * VS8 + (tid & 7) * 16;
    i32x4 pq0, pq1; u32x4 pk0, pv0, pk1, pv1;
#define C_SRC(U) const int b_ = (U) >> 7, kvh_ = ((U) >> 6) & 1, qb_ = (U) & 63; const size_t tokb_ = (size_t)b_ * SEQ; \
        const GAS unsigned char* qp_ = qkv8 + (tokb_ + 64 * qb_ + 32 * (wave & 1) + r32) * ROWB + QC8 + 64 * (4 * kvh_ + (wave >> 1)) + 32 * hi; \
        const GAS unsigned char* ksrc = qkv8 + (tokb_ + (tid >> 2)) * ROWB + QC8 + 512 + 64 * kvh_ + 16 * (tid & 3); \
        const GAS unsigned char* vsrc = vt8 + (size_t)((b_ * 2 + kvh_) * 64 + (tid >> 3)) * SEQ + 16 * (tid & 7)
#define C_PREFETCH(U) do { C_SRC(U); pq0 = *(const GAS i32x4*)qp_; pq1 = *(const GAS i32x4*)(qp_ + 16); pk0 = *(const GAS u32x4*)ksrc; pv0 = *(const GAS u32x4*)vsrc; \
        pk1 = *(const GAS u32x4*)(ksrc + (size_t)TK * ROWB); pv1 = *(const GAS u32x4*)(vsrc + TK); } while (0)
    int unit = xcd_vcu();
    if (unit < BATCH * 2 * 64) C_PREFETCH(unit);
    for (; unit < BATCH * 2 * 64; unit += gridDim.x) {
        const int b = unit >> 7, kvh = (unit >> 6) & 1, qb = unit & 63;
        const int head = 4 * kvh + (wave >> 1);
        const size_t tokb = (size_t)b * SEQ, tokq = tokb + 64 * qb + 32 * (wave & 1);
        const GAS unsigned char* ksrc = qkv8 + (tokb + (tid >> 2)) * ROWB + QC8 + 512 + 64 * kvh + 16 * (tid & 3);
        const GAS unsigned char* vsrc = vt8 + (size_t)((b * 2 + kvh) * 64 + (tid >> 3)) * SEQ + 16 * (tid & 7);
        u32x4 rk, rv;
        lds_barrier();
        *(LAS u32x4*)(lds + kdst) = pk0; *(LAS u32x4*)(lds + vdst) = pv0; *(LAS u32x4*)(lds + kdst + KB) = pk1; *(LAS u32x4*)(lds + vdst + VB) = pv1;
        const i32x8 qf = {pq0.x, pq0.y, pq0.z, pq0.w, pq1.x, pq1.y, pq1.z, pq1.w};
        lds_barrier();
        f32x16 o[2], l2;
#pragma unroll
        for (int r_ = 0; r_ < 16; ++r_) { o[0][r_] = 0.f; o[1][r_] = 0.f; l2[r_] = 0.f; }
        f32x16 SA, SB; i32x8 kf;
        { const i32x8 k0 = kf8_load((const LAS char*)(lds + L_K), lane); SA = MFMA8(k0, qf, negv); }
        kf = kf8_load((const LAS char*)(lds + L_K + 32 * KS8), lane);
        int sc = 0, sn = 1, sw = 2;
        for (int t = 0; t < NT - 1; ++t) {
            if (t + 2 < NT) { rk = *(const GAS u32x4*)(ksrc + (size_t)((t + 2) * TK) * ROWB); rv = *(const GAS u32x4*)(vsrc + (t + 2) * TK); }
            { const LAS char* Kc = (const LAS char*)(lds + L_K + sc * KB); const LAS char* Kn = (const LAS char*)(lds + L_K + sn * KB); const LAS char* Vc = (const LAS char*)(lds + L_V + sc * VB);
              attn_c_pair<true>(SA, SB, qf, kf, Kc + 64 * KS8, Kc + 96 * KS8, Vc, o, l2, negv, lane);
              attn_c_pair<true>(SA, SB, qf, kf, Kn, Kn + 32 * KS8, Vc + 64, o, l2, negv, lane); }
            if (t + 2 < NT) { *(LAS u32x4*)(lds + kdst + sw * KB) = rk; *(LAS u32x4*)(lds + vdst + sw * VB) = rv; }
            lds_barrier();
            const int tmp = sc; sc = sn; sn = sw; sw = tmp;
        }
        { const LAS char* Kc = (const LAS char*)(lds + L_K + sc * KB); const LAS char* Vc = (const LAS char*)(lds + L_V + sc * VB);
          attn_c_pair<true>(SA, SB, qf, kf, Kc + 64 * KS8, Kc + 96 * KS8, Vc, o, l2, negv, lane);
          attn_c_pair<false>(SA, SB, qf, kf, Kc, Kc, Vc + 64, o, l2, negv, lane); }
        { const int un_ = (unit + (int)gridDim.x < BATCH * 2 * 64) ? unit + (int)gridDim.x : unit; C_PREFETCH(un_); }
        {
          LAS bf16_t* stg = (LAS bf16_t*)(lds + L_STG + wave * 4096);
          GAS bf16_t* oCe = (GAS bf16_t*)(oq(a.ws) + WS_OBUF + OB_C);
          float lq = (l2[0] + l2[1]) + (l2[2] + l2[3]); lq += shx(lq, 32, lane); const float linv = 1.f / lq;
#pragma unroll
          for (int r_ = 0; r_ < 16; ++r_) { const int q = crow(r_, hi); const float f = shl(linv, q); stg[q * 64 + r32] = f2bf(o[0][r_] * f); stg[q * 64 + 32 + r32] = f2bf(o[1][r_] * f); }
          asm volatile("s_waitcnt lgkmcnt(0)" ::: "memory");
#pragma unroll
          for (int j = 0; j < 4; ++j) { const int c = lane + 64 * j, q = c >> 3, d8 = (c & 7) * 8; const u32x4 v = *(const LAS u32x4*)(stg + q * 64 + d8);
              *(GAS u32x4*)(oCe + (tokq + q) * 512 + 64 * head + d8) = v; } }
    }
#undef C_SRC
#undef C_PREFETCH
    __builtin_amdgcn_s_setprio(0);
}

__device__ __forceinline__ void p_mixnorm(const GArgs& a, int wv) {
    const int tid_ = otid(wv), lane = tid_ & 63, wave = rfl(tid_ >> 6);
    const GAS bf16_t* oA = (const GAS bf16_t*)(a.ws + WS_OBUF + OB_A); const GAS bf16_t* oC = (const GAS bf16_t*)(a.ws + WS_OBUF + OB_C); const GAS bf16_t* oB = (const GAS bf16_t*)(a.ws + WS_OBUF + OB_B);
    const GAS float* lB = (const GAS float*)(a.ws + WS_LB); GAS bf16_t* mb = (GAS bf16_t*)(a.ws + WS_MB);
    const int gw = blockIdx.x * NWAVES + wave, NGW = gridDim.x * NWAVES;
    constexpr int RB = 4;
    for (int row0 = gw * RB; row0 < NTOK; row0 += NGW * RB) {
        u32x2 wa[RB], wb[RB][3], wc[RB][2]; f32x4 lv[RB];
#pragma unroll
        for (int q = 0; q < RB; ++q) { const size_t row = row0 + q;
            wa[q] = *(const GAS u32x2*)(oA + row * 256 + 4 * lane);
#pragma unroll
            for (int br = 0; br < 3; ++br) wb[q][br] = *(const GAS u32x2*)(oB + ((size_t)br * NTOK + row) * 256 + 4 * lane);
            lv[q] = *(const GAS f32x4*)(lB + row * 16 + 4 * (lane >> 4));
#pragma unroll
            for (int j = 0; j < 2; ++j) wc[q][j] = *(const GAS u32x2*)(oC + row * 512 + 4 * lane + 256 * j); }
#pragma unroll
        for (int q = 0; q < RB; ++q) { const size_t row = row0 + q;
            f32x4 v[4];
            v[0] = (f32x4){bflo(wa[q].x), bfhi(wa[q].x), bflo(wa[q].y), bfhi(wa[q].y)};
            { f32x4 s = {0.f, 0.f, 0.f, 0.f};
#pragma unroll
              for (int br = 0; br < 3; ++br) s += (f32x4){bflo(wb[q][br].x), bfhi(wb[q][br].x), bflo(wb[q][br].y), bfhi(wb[q][br].y)};
              v[1] = s * (1.f / (lv[q].x + lv[q].y + lv[q].z)); }
#pragma unroll
            for (int j = 0; j < 2; ++j) v[2 + j] = (f32x4){bflo(wc[q][j].x), bfhi(wc[q][j].x), bflo(wc[q][j].y), bfhi(wc[q][j].y)};
            float sa = (v[0].x * v[0].x + v[0].y * v[0].y) + (v[0].z * v[0].z + v[0].w * v[0].w);
            float sb = (v[1].x * v[1].x + v[1].y * v[1].y) + (v[1].z * v[1].z + v[1].w * v[1].w);
            float sc = (v[2].x * v[2].x + v[2].y * v[2].y) + (v[2].z * v[2].z + v[2].w * v[2].w) + (v[3].x * v[3].x + v[3].y * v[3].y) + (v[3].z * v[3].z + v[3].w * v[3].w);
            sa = wave_sum(sa, lane); sb = wave_sum(sb, lane); sc = wave_sum(sc, lane);
            const float ra = 1.f / sqrtf(sa * (1.f / 256.f) + RMS_EPS), rb = 1.f / sqrtf(sb * (1.f / 256.f) + RMS_EPS), rc = 1.f / sqrtf(sc * (1.f / 512.f) + RMS_EPS);
            v[0] = v[0] * ra; v[1] = v[1] * rb; v[2] = v[2] * rc; v[3] = v[3] * rc;
#pragma unroll
            for (int j = 0; j < 4; ++j) { u32x2 o; o.x = pk2(v[j].x, v[j].y); o.y = pk2(v[j].z, v[j].w); *(GAS u32x2*)(mb + row * DM + 4 * lane + 256 * j) = o; } }
    }
}

constexpr int PPL = 10, N_PHASES = 2 + PPL * DEPTH;
__global__ void __launch_bounds__(NTHR, 2) fwd(Args a_unused) {
    extern __shared__ __attribute__((aligned(16))) unsigned char lds_raw[];
    LAS unsigned char* lds = (LAS unsigned char*)lds_raw;
    const int wv = rfl((int)threadIdx.x >> 6);
    const int tid = otid(wv);
    int lo, hi; unsigned* barw; { const GArgs a0 = kargs(); barw = (unsigned*)((GAS unsigned*)(a0.ws + WS_CTL) + CW_BAR + a0.li * XCD_BAR_WORDS); lo = a0.ph_lo; hi = a0.ph_hi; }
    if (tid < 16) ((LAS unsigned*)(lds + L_BARW))[tid] = 0u;
    __syncthreads();
    XcdBarrier bar; bar.bar = barw; bar.x = 0; bar.st = nullptr;
    if (hi - lo > 1) bar = xcd_barrier_post(barw, (volatile LAS unsigned*)(lds + L_BARW), tid == 0);
#ifdef PH_ONLY
#define PHSEL(j) ((j) == PH_ONLY)
#else
#define PHSEL(j) true
#endif
#define IN(p) (lo <= (p) && (p) < hi)
#define SEAM(p) do { if ((p) + 1 < hi) xcd_barrier(bar, otid(wv) == 0); } while (0)
#define SOFT(p) do { if ((p) + 1 < hi) __syncthreads(); } while (0)
#define PHASE_ENV const GArgs a = kargs(); GAS unsigned char* ws = a.ws; GAS unsigned* ctl = (GAS unsigned*)(ws + WS_CTL); GAS bf16_t* xb = (GAS bf16_t*)(ws + WS_XB); GAS bf16_t* mbuf = (GAS bf16_t*)(ws + WS_MB); GAS bf16_t* qkv = (GAS bf16_t*)(ws + WS_QKV); (void)ctl; (void)xb; (void)mbuf; (void)qkv

    if (PHSEL(100) && IN(0)) { { PHASE_ENV; p0_prologue(a, lds, wv); } SOFT(0); }
    for (int l = 0; l < DEPTH; ++l) {
        const int pb = 1 + PPL * l;
        if (PHSEL(0) && IN(pb + 0)) { { PHASE_ENV; p_combine(a, l, false, lds, wv); } SEAM(pb + 0); }
        if (PHSEL(1) && IN(pb + 1)) {
            { PHASE_ENV;
            FDense S{xb, (const GAS bf16_t*)(ws + WS_WIN) + (size_t)l * INC * DM, DM, NTOK / 256, INC / 256};
            EpiQKV E{(const GAS float*)(ws + WS_RSTD1), a.in[I_QKG] + (size_t)l * 384, (const GAS f32x2*)(ws + WS_ROPE), qkv, (GAS unsigned char*)(ws + WS_VT8)};
            { const int t_ = otid(wv); const f32x2 r0_ = E.rope[t_], r1_ = E.rope[t_ + NTHR]; LAS f32x2* rl_ = (LAS f32x2*)(lds + L_MISC); rl_[t_] = r0_; rl_[t_ + NTHR] = r1_; }
            gemm_fast(lds, S, E, DM, wv); }
            SEAM(pb + 1);
        }
        if (PHSEL(2) && IN(pb + 2)) { { PHASE_ENV; p_attn_a(a, l, lds, wv); } SOFT(pb + 2); }
        if (PHSEL(3) && IN(pb + 3)) { { PHASE_ENV; p_attn_b(a, l, lds, wv); } SOFT(pb + 3); }
        if (PHSEL(4) && IN(pb + 4)) { { PHASE_ENV; p_attn_c(a, l, lds, wv); } SEAM(pb + 4); }
        if (PHSEL(5) && IN(pb + 5)) { { PHASE_ENV; p_mixnorm(a, wv); } SEAM(pb + 5); }
        if (PHSEL(6) && IN(pb + 6)) {
            { PHASE_ENV;
            FDense S{mbuf, (const GAS bf16_t*)(ws + WS_WOUT) + (size_t)l * DM * DM, DM, NTOK / 256, DM / 256};
            EpiWout E{xb, (GAS float*)(ws + WS_SSQP)};
            gemm_fast(lds, S, E, DM, wv); }
            SEAM(pb + 6);
        }
        if (PHSEL(7) && IN(pb + 7)) { { PHASE_ENV; p_router(a, l, lds, wv); } SEAM(pb + 7); }
        if (PHSEL(8) && IN(pb + 8)) {
            { PHASE_ENV;
            moe_tables(ctl, l, lds, wv);
            FMoe S{xb, (const GAS bf16_t*)(ws + WS_WGU) + (size_t)l * NE * DM * DM, (size_t)DM * DM, DM, true};
            moe_units((const GAS int*)(ws + WS_LIST), true, lds, wv);
            EpiGU E{(const GAS float*)(ws + WS_RSLIST), (GAS bf16_t*)(ws + WS_OBUF)};
            gemm_fast(lds, S, E, DM, wv); }
            SEAM(pb + 8);
        }
        if (PHSEL(9) && IN(pb + 9)) {
            { PHASE_ENV;
            moe_tables(ctl, l, lds, wv);
            FMoe S{(const GAS bf16_t*)(ws + WS_OBUF), (const GAS bf16_t*)(ws + WS_WD) + (size_t)l * NE * DM * DE, (size_t)DM * DE, DE, false};
            moe_units((const GAS int*)(ws + WS_LIST), false, lds, wv);
            EpiDown E{(const GAS float*)(ws + WS_GLIST), qkv};
            gemm_fast(lds, S, E, DE, wv); }
            SEAM(pb + 9);
        }
    }
    if (PHSEL(101) && IN(N_PHASES - 1)) { PHASE_ENV; p_combine(a, DEPTH, true, lds, wv); }
#undef IN
#undef SEAM
#undef SOFT
}

extern "C" void kernel_launch(void* const* d_in, const int* in_sizes, int n_in, void* d_out, int out_size, void* d_ws, size_t ws_size, hipStream_t stream) {
    static int grid = 0;
    if (grid == 0) {
        if (n_in != 15 || in_sizes[0] != NTOK * DM || out_size != NTOK * DM || ws_size < WS_END) { fprintf(stderr, "kernel_launch: unexpected shapes (n_in %d, in0 %d, out %d, ws %zu)\n", n_in, n_in > 0 ? in_sizes[0] : -1, out_size, ws_size); grid = -1; return; }
        int dev = 0, cus = 0;
        if (hipGetDevice(&dev) != hipSuccess || hipDeviceGetAttribute(&cus, hipDeviceAttributeMultiprocessorCount, dev) != hipSuccess) { grid = -1; return; }
        if (hipFuncSetAttribute((const void*)fwd, hipFuncAttributeMaxDynamicSharedMemorySize, LDS_BYTES) != hipSuccess) { fprintf(stderr, "kernel_launch: hipFuncSetAttribute failed\n"); grid = -1; return; }
        int per_cu = 0;
        if (hipOccupancyMaxActiveBlocksPerMultiprocessor(&per_cu, (const void*)fwd, NTHR, LDS_BYTES) != hipSuccess || per_cu < 1) fprintf(stderr, "kernel_launch: occupancy query reports %d\n", per_cu);
        (void)hipGetLastError();
        grid = cus;
    }
    if (grid < 0) return;
    (void)hipMemsetAsync((char*)d_ws + WS_CTL, 0, CTL_ZERO_BYTES, stream);
    Args a{};
    for (int i = 0; i < 15; ++i) a.in[i] = (const float*)d_in[i];
    a.out = (float*)d_out; a.ws = (unsigned char*)d_ws;
    int li = 0;
    auto launch = [&](int lo, int hi) { a.ph_lo = lo; a.ph_hi = hi; a.li = li++; hipLaunchKernelGGL(fwd, dim3(grid), dim3(NTHR), LDS_BYTES, stream, a); };
#if PROBE_PHASE >= 0
    { int start = 0;
      for (int l = 0; l < DEPTH; ++l) { const int p = 1 + PPL * l + PROBE_PHASE; launch(start, p + 1); launch(p, p + 1); start = p + 1; }
      launch(start, N_PHASES); }
#elif MK_ONE_LAUNCH
    launch(0, N_PHASES);
#else
    for (int p = 0; p < N_PHASES; ++p) launch(p, p + 1);
#endif
}
```

```cpp
#include <hip/hip_runtime.h>
#include <cstdio>
#include <cstdint>

#ifndef PROBE_PHASE
#define PROBE_PHASE -1
#endif
#ifndef MK_ONE_LAUNCH
#define MK_ONE_LAUNCH 1
#endif

#define LAS __attribute__((address_space(3)))
#define GAS __attribute__((address_space(1)))
typedef unsigned short bf16_t;
typedef short bf16x8 __attribute__((ext_vector_type(8)));
typedef short s16x4 __attribute__((ext_vector_type(4)));
typedef short v4i16_t __attribute__((ext_vector_type(4)));
typedef float f32x2 __attribute__((ext_vector_type(2)));
typedef float f32x4 __attribute__((ext_vector_type(4)));
typedef float f32x16 __attribute__((ext_vector_type(16)));
typedef unsigned u32x2 __attribute__((ext_vector_type(2)));
typedef unsigned u32x4 __attribute__((ext_vector_type(4)));
typedef int i32x4 __attribute__((ext_vector_type(4)));
typedef int i32x2 __attribute__((ext_vector_type(2)));
typedef int i32x8 __attribute__((ext_vector_type(8)));
typedef __bf16 bf16x2_t __attribute__((ext_vector_type(2)));

constexpr int NTOK = 32768, DM = 1024, INC = 2304, NE = 32, DE = 512, DEPTH = 4, SEQ = 4096, BATCH = 8;
constexpr int NWAVES = 8, NTHR = 512;
constexpr float RMS_EPS = 1e-6f;
constexpr float LOG2E = 1.4426950408889634f;
constexpr float C2 = 0.125f * LOG2E;
constexpr int COL_QA = 0, COL_KA = 256, COL_VA = 512, COL_QB = 768, COL_KB = 1024, COL_VB = 1280, COL_QC = 1536, COL_KC = 2048, COL_VC = 2176;

constexpr size_t MiB = 1u << 20;
constexpr size_t WS_CTL = 0, CTL_ZERO_BYTES = 1 * MiB;
constexpr size_t WS_WIN = 2 * MiB;
constexpr size_t WS_WOUT = 20 * MiB;
constexpr size_t WS_WR = 28 * MiB;
constexpr size_t WS_ROPE = 29 * MiB;
constexpr size_t WS_RPBMAX = 29 * MiB + 64 * 1024;
constexpr size_t WS_WGU = 32 * MiB;
constexpr size_t WS_WD = 288 * MiB;
constexpr size_t WS_XB = 416 * MiB;
constexpr size_t WS_MB = 480 * MiB;
constexpr size_t WS_QKV = 544 * MiB;
constexpr size_t WS_OBUF = 688 * MiB;
constexpr size_t WS_LB = 784 * MiB;
constexpr size_t WS_RSTD1 = 786 * MiB;
constexpr size_t WS_RSTD2 = WS_RSTD1 + 256 * 1024;
constexpr size_t WS_SSQP = 787 * MiB;
constexpr size_t WS_LIST = 790 * MiB;
constexpr size_t WS_GLIST = 794 * MiB;
constexpr size_t WS_ASSIGN = 798 * MiB;
constexpr size_t WS_RSLIST = 800 * MiB;
constexpr size_t WS_VT8 = 804 * MiB;
constexpr size_t WS_X8 = 808 * MiB;
constexpr size_t WS_END = 840 * MiB;
constexpr size_t OB_A = 0, OB_C = (size_t)NTOK * 256 * 2, OB_B = OB_C + (size_t)NTOK * 512 * 2;
constexpr int CW_CNT = 1024;
constexpr int CW_BAR = 4096;

constexpr int LDS_BYTES = 163840;
constexpr int L_SCR = 0;
constexpr int L_MISC = 139264;
constexpr int L_BARW = LDS_BYTES - 64;

__device__ __forceinline__ int rfl(int v) { return __builtin_amdgcn_readfirstlane(v); }
__device__ __forceinline__ int otid(int wv) { unsigned z = 0u; asm volatile("" : "+v"(z)); return wv * 64 + (int)__builtin_amdgcn_mbcnt_hi(~0u, __builtin_amdgcn_mbcnt_lo(~0u, z)); }
template <class T> __device__ __forceinline__ T* oq(T* p) { asm volatile("" : "+s"(p)); return p; }
__device__ __forceinline__ unsigned pk2(float lo, float hi) { f32x2 v = {lo, hi}; bf16x2_t b = __builtin_convertvector(v, bf16x2_t); return __builtin_bit_cast(unsigned, b); }
__device__ __forceinline__ bf16_t f2bf(float f) { return (bf16_t)(pk2(f, 0.f) & 0xffffu); }
__device__ __forceinline__ float bflo(unsigned w) { return __uint_as_float(w << 16); }
__device__ __forceinline__ float bfhi(unsigned w) { return __uint_as_float(w & 0xffff0000u); }
__device__ __forceinline__ float shx(float v, int m, int lane) { return __int_as_float(__builtin_amdgcn_ds_bpermute((lane ^ m) << 2, __float_as_int(v))); }
__device__ __forceinline__ float shl(float v, int src) { return __int_as_float(__builtin_amdgcn_ds_bpermute(src << 2, __float_as_int(v))); }
__device__ __forceinline__ float wave_sum(float v, int lane) {
#pragma unroll
    for (int o = 1; o < 64; o <<= 1) v += shx(v, o, lane);
    return v;
}
__device__ __forceinline__ float wave_max(float v, int lane) {
#pragma unroll
    for (int o = 1; o < 64; o <<= 1) v = fmaxf(v, shx(v, o, lane));
    return v;
}
__device__ __forceinline__ void lds_barrier() { asm volatile("s_waitcnt lgkmcnt(0)\n\ts_barrier" ::: "memory"); }
__device__ __forceinline__ int xcd_vcu() { const int G = gridDim.x, c = blockIdx.x; return (G % 8 == 0) ? (c % 8) * (G / 8) + c / 8 : c; }
__device__ __forceinline__ int v_off(int row, int ch) { return row * 128 + ((ch ^ (((row >> 1) & 1) << 2)) * 16); }
__device__ __forceinline__ int crow(int r, int hi) { return (r & 3) + 8 * (r >> 2) + 4 * hi; }
#define MFMA32(a, b, c) __builtin_amdgcn_mfma_f32_32x32x16_bf16((a), (b), (c), 0, 0, 0)
#define MFMA16(a, b, c) __builtin_amdgcn_mfma_f32_16x16x32_bf16((a), (b), (c), 0, 0, 0)
__device__ __forceinline__ s16x4 vtr(const LAS char* p) { return __builtin_bit_cast(s16x4, __builtin_amdgcn_ds_read_tr16_b64_v4i16((LAS v4i16_t*)p)); }

#define XB_TMO      128
#define XB_XCNT(j)  (256  + 64 * (j))
#define XB_XSUB(j)  (1280 + 64 * (j))
#define XB_XGEN(j)  (2304 + 64 * (j))
#define XB_TOP      3328
#define XB_TOPGEN   3392
#define XCD_BAR_WORDS 3456
#define XB_SPIN_CAP (1u << 18)
__device__ __forceinline__ unsigned xb_ld(unsigned* p)              { return __hip_atomic_load(p, __ATOMIC_RELAXED, __HIP_MEMORY_SCOPE_AGENT); }
__device__ __forceinline__ unsigned xb_add(unsigned* p, unsigned v) { return __hip_atomic_fetch_add(p, v, __ATOMIC_RELAXED, __HIP_MEMORY_SCOPE_AGENT); }
__device__ __forceinline__ unsigned xb_xcc_id() { return (unsigned)__builtin_amdgcn_s_getreg((3 << 11) | 20) & 0xFu; }
#define XB_SPIN(cond, bar) do { unsigned _sp = 0; while (cond) { __builtin_amdgcn_s_sleep(1); \
    if ((++_sp & 255u) == 0u) { if (xb_ld(&(bar)[XB_TMO])) break; if (_sp > XB_SPIN_CAP) { atomicAdd(&(bar)[XB_TMO], 1u); break; } } } } while (0)
struct XcdBarrier { unsigned* bar; unsigned x; volatile LAS unsigned* st; };
__device__ __forceinline__ XcdBarrier xcd_barrier_post(unsigned* bar, volatile LAS unsigned* st, bool t0) {
    XcdBarrier b; b.bar = bar; b.x = xb_xcc_id(); b.st = st;
    if (t0) (void)xb_add(&bar[XB_XCNT(b.x)], 1u);
    return b;
}
__device__ __forceinline__ void xcd_barrier_complete(unsigned* bar, unsigned x, unsigned& nloc, unsigned& nx) {
    const unsigned G = gridDim.x * gridDim.y * gridDim.z;
    unsigned sum, cnt, mine, sp = 0u;
    for (;;) {
        sum = 0u; cnt = 0u; mine = 0u;
#pragma unroll
        for (unsigned j = 0; j < 16; ++j) { const unsigned c = xb_ld(&bar[XB_XCNT(j)]); sum += c; cnt += (c > 0u) ? 1u : 0u; mine = (j == x) ? c : mine; }
        if (sum == G) break;
        __builtin_amdgcn_s_sleep(1);
        if ((++sp & 255u) == 0u) { if (xb_ld(&bar[XB_TMO])) break; if (sp > XB_SPIN_CAP) { atomicAdd(&bar[XB_TMO], 1u); break; } }
    }
    nloc = mine > 0u ? mine : 1u; nx = cnt > 0u ? cnt : 1u;
}
__device__ __forceinline__ void xcd_barrier(const XcdBarrier& b, bool t0) {
    asm volatile("s_waitcnt vmcnt(0)" ::: "memory");
    __syncthreads();
    if (t0) {
        unsigned* bar = b.bar;
        __builtin_amdgcn_s_waitcnt(0);
        unsigned nloc = b.st[0], nx = b.st[1];
        if (nloc == 0u) { xcd_barrier_complete(bar, b.x, nloc, nx); b.st[0] = nloc; b.st[1] = nx; }
        const unsigned old = xb_add(&bar[XB_XSUB(b.x)], 1u);
        const unsigned gen = old / nloc;
        if (old + 1u == (gen + 1u) * nloc) {
            __builtin_amdgcn_fence(__ATOMIC_RELEASE, "agent");
            asm volatile("s_waitcnt vmcnt(0)" ::: "memory");
            const unsigned og = xb_add(&bar[XB_TOP], 1u);
            const unsigned tg = og / nx;
            if (og + 1u == (tg + 1u) * nx) xb_add(&bar[XB_TOPGEN], 1u);
            else XB_SPIN(xb_ld(&bar[XB_TOPGEN]) == tg, bar);
            __builtin_amdgcn_fence(__ATOMIC_ACQUIRE, "agent");
            xb_add(&bar[XB_XGEN(b.x)], 1u);
            asm volatile("s_waitcnt vmcnt(0)" ::: "memory");
        } else {
            XB_SPIN(xb_ld(&bar[XB_XGEN(b.x)]) == gen, bar);
            __builtin_amdgcn_fence(__ATOMIC_ACQUIRE, "agent");
            asm volatile("s_waitcnt vmcnt(0)" ::: "memory");
        }
    }
    __syncthreads();
}

struct Args { const float* in[15]; float* out; unsigned char* ws; int ph_lo, ph_hi, li, pad; };
struct GArgs { const GAS float* in[15]; GAS float* out; GAS unsigned char* ws; int ph_lo, ph_hi, li, pad; };
__device__ __forceinline__ GArgs kargs() {
    GArgs r;
#if defined(__HIP_DEVICE_COMPILE__)
    typedef const __attribute__((address_space(4))) unsigned long long* CU64P;
    CU64P p = (CU64P)__builtin_amdgcn_kernarg_segment_ptr(); asm volatile("" : "+s"(p));
    unsigned long long* d = (unsigned long long*)&r;
#pragma unroll
    for (int i = 0; i < (int)(sizeof(Args) / 8); ++i) d[i] = p[i];
#endif
    return r;
}
enum { I_X = 0, I_N1G, I_WIN, I_QKG, I_RPB, I_MIXG, I_WOUT, I_N2G, I_WRG, I_BRG, I_WRE, I_BRE, I_WG, I_WU, I_WDN };

__device__ __forceinline__ int slot32(int j) { return 16 * ((j >> 2) & 1) + 4 * (j >> 3) + (j & 3); }
__device__ __forceinline__ int destrow(int mode, int c) {
    if (mode == 1) { const int j = c & 31; const bool rope = (c >= COL_QC) && (c < COL_VC);
        return (c & ~255) + ((c >> 5) & 1) * 128 + ((c >> 6) & 3) * 32 + (rope ? j : slot32(j)); }
    if (mode == 2) return 256 * (c >> 7) + (c & 96) + slot32(c & 31);
    if (mode == 3) return 256 * (c >> 7) + 128 + (c & 96) + slot32(c & 31);
    return (c & ~31) + slot32(c & 31);
}
template <bool F8>
__device__ __forceinline__ void tp_item(const GAS float* W, int K, int N, GAS bf16_t* WT, const GAS float* kscale, int mode, LAS float* scr, int item, int lane) {
    const int nblk = N / 32, kb = item / nblk, nb = item % nblk, k0 = 64 * kb, n0 = 32 * nb;
    float wv_[32];
#pragma unroll
    for (int i = 0; i < 32; ++i) wv_[i] = W[(size_t)(k0 + 2 * i + (lane >> 5)) * N + n0 + (lane & 31)];
#pragma unroll
    for (int i = 0; i < 32; ++i) { const int kk = 2 * i + (lane >> 5); const float s = kscale ? kscale[k0 + kk] : 1.f; scr[kk * 33 + (lane & 31)] = wv_[i] * s; }
    asm volatile("s_waitcnt lgkmcnt(0)" ::: "memory");
    if (F8) {
        const int c = lane & 3;
#pragma unroll
        for (int j = 0; j < 2; ++j) { const int n = (lane >> 2) + 16 * j; const LAS float* s = scr + (16 * c) * 33 + n;
            int w[4];
#pragma unroll
            for (int q = 0; q < 4; ++q) { w[q] = __builtin_amdgcn_cvt_pk_fp8_f32(s[(4 * q) * 33] * 64.f, s[(4 * q + 1) * 33] * 64.f, 0, false); w[q] = __builtin_amdgcn_cvt_pk_fp8_f32(s[(4 * q + 2) * 33] * 64.f, s[(4 * q + 3) * 33] * 64.f, w[q], true); }
            *(GAS i32x4*)((GAS unsigned char*)WT + (size_t)destrow(mode, n0 + n) * K + k0 + 16 * c) = (i32x4){w[0], w[1], w[2], w[3]}; }
    } else {
        const int c = lane & 7;
#pragma unroll
        for (int j = 0; j < 4; ++j) { const int n = (lane >> 3) + 8 * j; const LAS float* s = scr + (8 * c) * 33 + n;
            u32x4 o; o.x = pk2(s[0 * 33], s[1 * 33]); o.y = pk2(s[2 * 33], s[3 * 33]); o.z = pk2(s[4 * 33], s[5 * 33]); o.w = pk2(s[6 * 33], s[7 * 33]);
            *(GAS u32x4*)(WT + (size_t)destrow(mode, n0 + n) * K + k0 + 8 * c) = o; }
    }
    asm volatile("s_waitcnt lgkmcnt(0)" ::: "memory");
}
__device__ __forceinline__ void p0_prologue(const GArgs& a, LAS unsigned char* lds, int wv) {
    const int tid_ = otid(wv), lane = tid_ & 63, wave = rfl(tid_ >> 6);
    LAS float* scr = (LAS float*)(lds + wave * 16384);
    const int gw = blockIdx.x * NWAVES + wave, NGW = gridDim.x * NWAVES;
    GAS unsigned char* ws = a.ws;
    constexpr int I_IN = 16 * 72, I_OUT = 16 * 32, I_E = 256, PER_L = I_IN + I_OUT + NE * 3 * I_E;
    for (int it = gw; it < DEPTH * PER_L; it += NGW) {
        const int l = it / PER_L; int r = it % PER_L;
        if (r < I_IN) { tp_item<false>(a.in[I_WIN] + (size_t)l * DM * INC, DM, INC, (GAS bf16_t*)(ws + WS_WIN) + (size_t)l * INC * DM, a.in[I_N1G] + l * DM, 1, scr, r, lane); continue; } r -= I_IN;
        if (r < I_OUT) { tp_item<false>(a.in[I_WOUT] + (size_t)l * DM * DM, DM, DM, (GAS bf16_t*)(ws + WS_WOUT) + (size_t)l * DM * DM, a.in[I_MIXG] + l * DM, 0, scr, r, lane); continue; } r -= I_OUT;
        const int e = r / (3 * I_E), rr = r % (3 * I_E), which = rr / I_E, item = rr % I_E; const size_t le = (size_t)l * NE + e;
        if (which == 0)      tp_item<true>(a.in[I_WG] + le * DM * DE, DM, DE, (GAS bf16_t*)((GAS unsigned char*)(ws + WS_WGU) + le * DM * DM), a.in[I_N2G] + l * DM, 2, scr, item, lane);
        else if (which == 1) tp_item<true>(a.in[I_WU] + le * DM * DE, DM, DE, (GAS bf16_t*)((GAS unsigned char*)(ws + WS_WGU) + le * DM * DM), a.in[I_N2G] + l * DM, 3, scr, item, lane);
        else                 tp_item<true>(a.in[I_WDN] + le * DE * DM, DE, DM, (GAS bf16_t*)((GAS unsigned char*)(ws + WS_WD) + le * DM * DE), nullptr, 0, scr, item, lane);
    }
    const int gt = blockIdx.x * NTHR + tid_, NGT = gridDim.x * NTHR;
    for (int idx = gt; idx < DEPTH * 36 * DM; idx += NGT) {
        const int l = idx / (36 * DM), n = (idx / DM) % 36, k = idx % DM;
        const float w = (n < 4) ? a.in[I_WRG][((size_t)l * DM + k) * 4 + n] : a.in[I_WRE][((size_t)l * DM + k) * 32 + (n - 4)];
        ((GAS bf16_t*)(ws + WS_WR))[((size_t)l * 64 + n) * DM + k] = f2bf(w * a.in[I_N2G][l * DM + k]);
    }
    if (wave == 0 && blockIdx.x < DEPTH) { const GAS float* rp = a.in[I_RPB] + (size_t)blockIdx.x * 1860; float mx = 0.f;
        for (int i = lane; i < 1860; i += 64) mx = fmaxf(mx, fabsf(rp[i]));
        mx = wave_max(mx, lane);
        const GAS float* qg = a.in[I_QKG] + (size_t)blockIdx.x * 384;
        const float ba = wave_max(fabsf(qg[lane]), lane) * wave_max(fabsf(qg[64 + lane]), lane), bb_ = wave_max(fabsf(qg[128 + lane]), lane) * wave_max(fabsf(qg[192 + lane]), lane),
                    bc = wave_max(fabsf(qg[256 + lane]), lane) * wave_max(fabsf(qg[320 + lane]), lane);
        const float gqc = qg[256 + lane], gkc = qg[320 + lane]; const float sigc = LOG2E * sqrtf(wave_sum(gqc * gqc * gkc * gkc, lane) * (1.f / 64.f));
        if (lane == 0) { GAS float* mr = (GAS float*)(ws + WS_RPBMAX) + 4 * blockIdx.x; mr[0] = (8.f * ba + mx) * LOG2E; mr[1] = 8.f * bb_ * LOG2E; mr[2] = fminf(9.f * sigc, 1.15f * 8.f * bc * LOG2E) - 8.75f; mr[3] = mx; } }
    if (gt < 64 * 16) {
        const int pos = gt >> 4, f = gt & 15;
        double inv = 1.0; for (int i = 0; i < f; ++i) inv *= 0.56234132519034908;
        const float invf = (float)inv; const float angf = (float)pos * invf;
        const double x = (double)angf;
        const double kq = __builtin_rint(x * 0.63661977236758134);
        const double rr = (x - kq * 1.5707963267341256) - kq * 6.0771005065061922e-11;
        const double r2 = rr * rr;
        double sn = rr * (1.0 + r2 * (-1.0 / 6 + r2 * (1.0 / 120 + r2 * (-1.0 / 5040 + r2 * (1.0 / 362880 + r2 * (-1.0 / 39916800 + r2 * (1.0 / 6227020800.0)))))));
        double cs = 1.0 + r2 * (-0.5 + r2 * (1.0 / 24 + r2 * (-1.0 / 720 + r2 * (1.0 / 40320 + r2 * (-1.0 / 3628800 + r2 * (1.0 / 479001600.0 + r2 * (-1.0 / 87178291200.0)))))));
        const int q = ((int)kq) & 3; double c, s;
        if (q == 0) { c = cs; s = sn; } else if (q == 1) { c = -sn; s = cs; } else if (q == 2) { c = -cs; s = -sn; } else { c = sn; s = -cs; }
        ((GAS f32x2*)(ws + WS_ROPE))[gt] = (f32x2){(float)c, (float)s};
    }
}

constexpr int LM_CNT = L_MISC, LM_TPRE = L_MISC + 128, LM_TOKL = L_MISC + 512, LM_GL = L_MISC + 512 + 1024, LM_RC = L_MISC + 512 + 2048, LM_RB = LM_RC + 128;
__device__ __forceinline__ void moe_tables(const GAS unsigned* ctl, int l, LAS unsigned char* lds, int wv) {
    LAS int* cnt = (LAS int*)(lds + LM_CNT); LAS int* tpre = (LAS int*)(lds + LM_TPRE);
    const int tid = otid(wv);
    __syncthreads();
    if (tid < 32) cnt[tid] = (int)__hip_atomic_load(ctl + CW_CNT + 64 * l + tid, __ATOMIC_RELAXED, __HIP_MEMORY_SCOPE_AGENT);
    __syncthreads();
    if (tid < 64) {
        const int lane = tid; int v = (lane < 32) ? ((cnt[lane & 31] + 255) >> 8) : 0; const int own = v;
#pragma unroll
        for (int o = 1; o < 32; o <<= 1) { const int t = __builtin_amdgcn_ds_bpermute(((lane - o) & 63) << 2, v); if (lane >= o) v += t; }
        if (lane < 32) tpre[lane] = v - own;
        if (lane == 31) tpre[32] = v;
    }
    __syncthreads();
}

__device__ __forceinline__ void p_combine(const GArgs& a, int l, bool final_, LAS unsigned char* lds, int wv) {
    const int tid_ = otid(wv), lane = tid_ & 63, wave = rfl(tid_ >> 6);
    GAS unsigned char* ws = oq(a.ws);
    const bool comb = (l > 0);
    const GAS bf16_t* Y = (const GAS bf16_t*)(ws + WS_QKV);
    const GAS int* assign = (const GAS int*)(ws + WS_ASSIGN);
    GAS bf16_t* xb = (GAS bf16_t*)(ws + WS_XB); GAS float* rstd1 = (GAS float*)(ws + WS_RSTD1);
    if (comb) moe_tables((const GAS unsigned*)(ws + WS_CTL), l - 1, lds, wv);
    const LAS int* tpre = (const LAS int*)(lds + LM_TPRE);
    const int gw = blockIdx.x * NWAVES + wave, NGW = gridDim.x * NWAVES;
    constexpr int RB = 4;
    for (int row0 = gw * RB; row0 < NTOK; row0 += NGW * RB) {
        f32x4 v[RB][4];
        if (!comb) {
#pragma unroll
            for (int q = 0; q < RB; ++q)
#pragma unroll
                for (int j = 0; j < 4; ++j) v[q][j] = *(const GAS f32x4*)(a.in[I_X] + (size_t)(row0 + q) * DM + 4 * lane + 256 * j);
        } else {
            i32x4 as[RB]; u32x2 x0[RB][4], y0[RB][4], y1[RB][4];
#pragma unroll
            for (int q = 0; q < RB; ++q) as[q] = *(const GAS i32x4*)(assign + (row0 + q) * 4);
#pragma unroll
            for (int q = 0; q < RB; ++q)
#pragma unroll
                for (int j = 0; j < 4; ++j) x0[q][j] = *(const GAS u32x2*)(xb + (size_t)(row0 + q) * DM + 4 * lane + 256 * j);
#pragma unroll
            for (int q = 0; q < RB; ++q) { const size_t s0 = (size_t)tpre[as[q].x] * 256 + as[q].y, s1 = (size_t)tpre[as[q].z] * 256 + as[q].w;
#pragma unroll
                for (int j = 0; j < 4; ++j) { y0[q][j] = *(const GAS u32x2*)(Y + s0 * DM + 4 * lane + 256 * j); y1[q][j] = *(const GAS u32x2*)(Y + s1 * DM + 4 * lane + 256 * j); } }
#pragma unroll
            for (int q = 0; q < RB; ++q)
#pragma unroll
                for (int j = 0; j < 4; ++j) {
                    v[q][j].x = bflo(x0[q][j].x) + bflo(y0[q][j].x) + bflo(y1[q][j].x); v[q][j].y = bfhi(x0[q][j].x) + bfhi(y0[q][j].x) + bfhi(y1[q][j].x);
                    v[q][j].z = bflo(x0[q][j].y) + bflo(y0[q][j].y) + bflo(y1[q][j].y); v[q][j].w = bfhi(x0[q][j].y) + bfhi(y0[q][j].y) + bfhi(y1[q][j].y); }
        }
#pragma unroll
        for (int q = 0; q < RB; ++q) {
            const int row = row0 + q;
            if (final_) {
#pragma unroll
                for (int j = 0; j < 4; ++j) *(GAS f32x4*)(a.out + (size_t)row * DM + 4 * lane + 256 * j) = v[q][j];
            } else {
                float s = 0.f;
#pragma unroll
                for (int j = 0; j < 4; ++j) s += (v[q][j].x * v[q][j].x + v[q][j].y * v[q][j].y) + (v[q][j].z * v[q][j].z + v[q][j].w * v[q][j].w);
                s = wave_sum(s, lane);
                if (lane == 0) rstd1[row] = 1.f / sqrtf(s * (1.f / DM) + RMS_EPS);
#pragma unroll
                for (int j = 0; j < 4; ++j) { u32x2 o; o.x = pk2(v[q][j].x, v[q][j].y); o.y = pk2(v[q][j].z, v[q][j].w); *(GAS u32x2*)(xb + (size_t)row * DM + 4 * lane + 256 * j) = o; }
            }
        }
    }
}

struct GUnit { int pm, pn, e, T, rbase, nai, ord; };
constexpr int G_AS = 0, G_BS = 20480, G_ROWB = 80;
template <class Sched, class Epi>
__device__ __forceinline__ void gemm_simple(LAS unsigned char* lds, const Sched& S, const Epi& E, const int K, int wv) {
    const int tid = otid(wv), wid = rfl(tid >> 6), lane = tid & 63, wr = wid >> 2, wc = wid & 3, fr = lane & 15, fq = lane >> 4;
    GUnit u;
    for (int ui = 0; S.next(ui, u, lds); ++ui) {
        S.begin(u, lds);
        const GAS bf16_t* ap[2]; const GAS bf16_t* bp[2]; bool bv[2];
        const int nbv = S.b_valid(u);
#pragma unroll
        for (int i = 0; i < 2; ++i) { const int r = (tid >> 2) + 128 * i; ap[i] = S.a_row(u, r, lds) + (tid & 3) * 8; bp[i] = S.b_row(u, r) + (tid & 3) * 8; bv[i] = r < nbv; }
        f32x4 acc[2][2][4][2];
#pragma unroll
        for (int x = 0; x < 2; ++x)
#pragma unroll
            for (int y = 0; y < 2; ++y)
#pragma unroll
                for (int m = 0; m < 4; ++m)
#pragma unroll
                    for (int n = 0; n < 2; ++n) acc[x][y][m][n] = (f32x4){0.f, 0.f, 0.f, 0.f};
        for (int kt = 0; kt < K / 32; ++kt) {
            u32x4 ra[2], rb[2];
#pragma unroll
            for (int i = 0; i < 2; ++i) { ra[i] = *(const GAS u32x4*)(ap[i] + kt * 32); rb[i] = bv[i] ? *(const GAS u32x4*)(bp[i] + kt * 32) : (u32x4){0u, 0u, 0u, 0u}; }
            __syncthreads();
#pragma unroll
            for (int i = 0; i < 2; ++i) { const int r = (tid >> 2) + 128 * i;
                *(LAS u32x4*)(lds + G_AS + r * G_ROWB + (tid & 3) * 16) = ra[i];
                *(LAS u32x4*)(lds + G_BS + r * G_ROWB + (tid & 3) * 16) = rb[i]; }
            __syncthreads();
#pragma unroll
            for (int ai = 0; ai < 2; ++ai) {
                bf16x8 At[4];
#pragma unroll
                for (int m = 0; m < 4; ++m) At[m] = *(const LAS bf16x8*)(lds + G_AS + (128 * ai + 64 * wr + 16 * m + fr) * G_ROWB + 16 * fq);
#pragma unroll
                for (int bj = 0; bj < 2; ++bj) {
                    bf16x8 Bt[2];
#pragma unroll
                    for (int n = 0; n < 2; ++n) Bt[n] = *(const LAS bf16x8*)(lds + G_BS + (128 * bj + 32 * wc + 16 * n + fr) * G_ROWB + 16 * fq);
#pragma unroll
                    for (int m = 0; m < 4; ++m)
#pragma unroll
                        for (int n = 0; n < 2; ++n) acc[ai][bj][m][n] = MFMA16(Bt[n], At[m], acc[ai][bj][m][n]);
                }
            }
        }
        E(acc, u, lds, wid, lane);
    }
}

namespace fg {
constexpr int BK = 64, HALF = 128, HTB = HALF * BK * 2;
__device__ __forceinline__ int lds_byte(int r, int c) { const int st = (r >> 4) * 2 + (c >> 5), rr = r & 15, cc = c & 31, ob = rr * 64 + cc * 2; return st * 1024 + (ob ^ (((ob >> 9) & 1) << 5)); }
__device__ __forceinline__ void stage_rc(int b, int& R, int& C) { const int st = b / 1024, sb = b % 1024, swz = sb ^ (((sb >> 9) & 1) << 5); R = (st >> 1) * 16 + swz / 64; C = (st & 1) * 32 + (swz % 64) / 2; }
}
template <bool F8, class Sched, class Epi>
__device__ __forceinline__ void gemm_fast(LAS unsigned char* lds, const Sched& S, const Epi& E, const int K, int wv) {
    using namespace fg;
    const int tid = otid(wv), wid = rfl(tid >> 6), lane = tid & 63, wr = wid >> 2, wc = wid & 3, fr = lane & 15, fq = lane >> 4;
    int nt = K / BK; asm volatile("" : "+s"(nt));
    unsigned voffB[2];
#pragma unroll
    for (int i = 0; i < 2; ++i) { int R_, C_; stage_rc(tid * 16 + i * 8192, R_, C_); voffB[i] = (unsigned)(R_ * K + C_) * 2u; }
    const size_t kstep = (size_t)(BK * 2), hstep = (size_t)HALF * K * 2;
    const unsigned ldsw = (unsigned)wid * 1024u;
    const int aoff = lds_byte(wr * 64 + fr, fq * 8), boff = lds_byte(wc * 32 + fr, fq * 8);
#define FG_SA(b, h) (((b) * 2 + (h)) * HTB)
#define FG_SB(b, h) ((4 + (b) * 2 + (h)) * HTB)
#define FG_STAGE(bufoff, gbase, voff) do { _Pragma("unroll") for (int _i = 0; _i < 2; ++_i) \
        __builtin_amdgcn_global_load_lds((const GAS unsigned*)((const GAS char*)(gbase) + (voff)[_i]), (LAS unsigned*)(lds + (bufoff) + ldsw + _i * 8192), 16, 0, 0); } while (0)
#define FG_LDA(dst, b, h) do { _Pragma("unroll") for (int m = 0; m < 4; ++m) _Pragma("unroll") for (int k = 0; k < 2; ++k) dst[m][k] = *(const LAS bf16x8*)(lds + FG_SA(b, h) + aoff + m * 2048 + k * 1024); } while (0)
#define FG_LDB(dst, b, h) do { _Pragma("unroll") for (int n = 0; n < 2; ++n) _Pragma("unroll") for (int k = 0; k < 2; ++k) dst[n][k] = *(const LAS bf16x8*)(lds + FG_SB(b, h) + boff + n * 2048 + k * 1024); } while (0)
#define FG_L8(p_) __builtin_shufflevector(*(const LAS i32x4*)(p_), *(const LAS i32x4*)((p_) + 1024), 0, 1, 2, 3, 4, 5, 6, 7)
#define FG_LDA8(dst, b, h) do { _Pragma("unroll") for (int m = 0; m < 4; ++m) dst[m] = FG_L8(lds + FG_SA(b, h) + aoff + m * 2048); } while (0)
#define FG_LDB8(dst, b, h) do { _Pragma("unroll") for (int n = 0; n < 2; ++n) dst[n] = FG_L8(lds + FG_SB(b, h) + boff + n * 2048); } while (0)
#define FG_MMA8(ai, bj, At_, Bt_) do { __builtin_amdgcn_s_setprio(1); _Pragma("unroll") for (int m = 0; m < 4; ++m) _Pragma("unroll") for (int n = 0; n < 2; ++n) \
        asm volatile("v_mfma_scale_f32_16x16x128_f8f6f4 %0, %1, %2, %0, %3, %4 op_sel_hi:[0,0,0]" : "+v"(acc[ai][bj][m][n]) : "v"(Bt_[n]), "v"(At_[m]), "v"(sclw), "v"(scla)); __builtin_amdgcn_s_setprio(0); } while (0)
#define FG_MMA(ai, bj, At, Bt) do { __builtin_amdgcn_s_setprio(1); _Pragma("unroll") for (int m = 0; m < 4; ++m) _Pragma("unroll") for (int n = 0; n < 2; ++n) _Pragma("unroll") for (int k = 0; k < 2; ++k) \
        acc[ai][bj][m][n] = MFMA16(Bt[n][k], At[m][k], acc[ai][bj][m][n]); __builtin_amdgcn_s_setprio(0); } while (0)
#define FG_WAIT_V(n) asm volatile("s_waitcnt vmcnt(" #n ")" ::: "memory")
#define FG_WAIT_L(n) asm volatile("s_waitcnt lgkmcnt(" #n ")" ::: "memory")
#define FG_BAR __builtin_amdgcn_s_barrier()
#define FG_SCHED __builtin_amdgcn_sched_barrier(0)
    GUnit cur, nxt; int ui = 0;
    if (!S.next(0, cur, lds)) return;
    f32x4 acc[2][2][4][2];
#pragma unroll
    for (int x = 0; x < 2; ++x)
#pragma unroll
        for (int y = 0; y < 2; ++y)
#pragma unroll
            for (int m = 0; m < 4; ++m)
#pragma unroll
                for (int n = 0; n < 2; ++n) acc[x][y][m][n] = (f32x4){0.f, 0.f, 0.f, 0.f};
    bf16x8 At[4][2], B0[2][2], B1[2][2];
    i32x8 A8[4], B80[2], B81[2];
    int sclw = 0x79797979, scla = 0x7F7F7F7F; asm volatile("" : "+v"(sclw), "+v"(scla));
    const GAS char* Ab = (const GAS char*)S.a_base();
    unsigned vc[2][2];
    S.a_off(cur, lds, tid, vc);
    const GAS char* cB = (const GAS char*)S.b_ptr(cur);
    FG_STAGE(FG_SB(0, 0), cB, voffB); FG_STAGE(FG_SB(0, 1), cB + hstep, voffB); FG_STAGE(FG_SA(0, 0), Ab, vc[0]); FG_STAGE(FG_SA(0, 1), Ab, vc[1]);
    if (wr == 1) FG_BAR;
    FG_WAIT_V(2); FG_BAR;
    FG_STAGE(FG_SB(1, 0), cB + kstep, voffB); FG_STAGE(FG_SA(1, 0), Ab + kstep, vc[0]); FG_STAGE(FG_SB(1, 1), cB + hstep + kstep, voffB);
    FG_WAIT_V(6); FG_BAR;
    for (;;) {
        const bool has_next = S.next(ui + 1, nxt, lds);
        const GAS char* nB = has_next ? (const GAS char*)S.b_ptr(nxt) : cB;
        const bool full = cur.nai == 2;
#pragma unroll 1
        for (int t = 0; t < nt; t += 2) {
            const bool last = (t == nt - 2);
            const GAS char* a1 = Ab + (size_t)(t + 1) * kstep;
            const GAS char* a2 = last ? Ab : Ab + (size_t)(t + 2) * kstep; const GAS char* b2 = last ? nB : cB + (size_t)(t + 2) * kstep;
            const GAS char* a3 = a2 + kstep; const GAS char* b3 = b2 + kstep;
            const unsigned va1[2] = {vc[1][0], vc[1][1]};
            if (last && has_next) S.a_off(nxt, lds, tid, vc);
#define FG_XLDB(b_) do { if (F8) { FG_LDB8(B80, b_, 0); FG_LDB8(B81, b_, 1); } else { FG_LDB(B0, b_, 0); FG_LDB(B1, b_, 1); } } while (0)
#define FG_XLDA(b_, h_) do { if (F8) FG_LDA8(A8, b_, h_); else FG_LDA(At, b_, h_); } while (0)
#define FG_XMMA(ai_) do { if (F8) { FG_MMA8(ai_, 0, A8, B80); FG_MMA8(ai_, 1, A8, B81); } else { FG_MMA(ai_, 0, At, B0); FG_MMA(ai_, 1, At, B1); } } while (0)
            FG_XLDB(0); FG_SCHED; FG_XLDA(0, 0); FG_STAGE(FG_SA(1, 1), a1, va1);
            FG_WAIT_V(8); FG_WAIT_L(0); FG_BAR; FG_XMMA(0); FG_BAR; FG_SCHED;
            FG_XLDA(0, 1); FG_STAGE(FG_SB(0, 0), b2, voffB); FG_STAGE(FG_SB(0, 1), b2 + hstep, voffB); FG_STAGE(FG_SA(0, 0), a2, vc[0]);
            FG_WAIT_V(8); FG_WAIT_L(0); FG_BAR; if (full) { FG_XMMA(1); } FG_BAR; FG_SCHED;
            FG_XLDB(1); FG_SCHED; FG_XLDA(1, 0); FG_STAGE(FG_SA(0, 1), a2, vc[1]);
            FG_WAIT_V(8); FG_WAIT_L(0); FG_BAR; FG_XMMA(0); FG_BAR; FG_SCHED;
            FG_XLDA(1, 1); FG_STAGE(FG_SB(1, 0), b3, voffB); FG_STAGE(FG_SB(1, 1), b3 + hstep, voffB); FG_STAGE(FG_SA(1, 0), a3, vc[0]);
            FG_WAIT_V(8); FG_WAIT_L(0); FG_BAR; if (full) { FG_XMMA(1); } FG_BAR; FG_SCHED;
#undef FG_XLDB
#undef FG_XLDA
#undef FG_XMMA
        }
        if (wr == 0) FG_BAR;
        if (F8) { asm volatile("s_nop 15\n\ts_nop 15\n\ts_nop 15" ::: "memory"); }
        E(acc, cur, lds, wid, lane);
        if (!has_next) break;
#pragma unroll
        for (int x = 0; x < 2; ++x)
#pragma unroll
            for (int y = 0; y < 2; ++y)
#pragma unroll
                for (int m = 0; m < 4; ++m)
#pragma unroll
                    for (int n = 0; n < 2; ++n) acc[x][y][m][n] = (f32x4){0.f, 0.f, 0.f, 0.f};
        cur = nxt; cB = nB; ++ui;
        if (wr == 1) FG_BAR;
    }
    FG_WAIT_V(0);
    FG_BAR;
#undef FG_SA
#undef FG_SB
#undef FG_STAGE
#undef FG_LDA
#undef FG_LDB
#undef FG_MMA
#undef FG_L8
#undef FG_LDA8
#undef FG_LDB8
#undef FG_MMA8
#undef FG_WAIT_V
#undef FG_WAIT_L
#undef FG_BAR
#undef FG_SCHED
}
struct FDense {
    const GAS bf16_t* A; const GAS bf16_t* Bt; int K, nM, nN;
    __device__ __forceinline__ bool next(int i, GUnit& u, LAS unsigned char*) const {
        const int nwg = nM * nN, G = (int)gridDim.x, nfull = (nwg / G) * G; const int L = i * G + (int)blockIdx.x;
        int wgid = L; u.rbase = 0; u.nai = 2; u.ord = i;
        if (L >= nfull) { const int r = L - nfull; wgid = nfull + (r >> 1); if (wgid >= nwg) return false; u.rbase = 128 * (r & 1); u.nai = 1; }
        { const int q = nwg / 8, r = nwg % 8, xcd = wgid % 8, off = wgid / 8; wgid = (xcd < r ? xcd * (q + 1) : r * (q + 1) + (xcd - r) * q) + off; }
        const int nig = 8 * nN, gid = wgid / nig, fm = gid * 8, gsz = (nM - fm) < 8 ? (nM - fm) : 8;
        u.pm = fm + ((wgid % nig) % gsz); u.pn = (wgid % nig) / gsz; u.e = 0; u.T = 0; return true;
    }
    __device__ __forceinline__ const GAS bf16_t* a_base() const { return A; }
    __device__ __forceinline__ void a_off(const GUnit& u, LAS unsigned char*, int tid, unsigned (&off)[2][2]) const {
#pragma unroll
        for (int i = 0; i < 2; ++i) { int R, C; fg::stage_rc(tid * 16 + i * 8192, R, C);
#pragma unroll
            for (int h = 0; h < 2; ++h) off[h][i] = (unsigned)((256 * u.pm + u.rbase + (u.nai == 2 ? 128 * h : 0) + R) * K + C) * 2u; }
    }
    __device__ __forceinline__ const GAS bf16_t* b_ptr(const GUnit& u) const { return Bt + (size_t)256 * u.pn * K; }
};
constexpr int LM_FT = L_MISC + 512;
constexpr int LM_UT = L_MISC + 512 + 5120;
struct FMoe {
    const GAS bf16_t* A; const GAS bf16_t* Bt; size_t bstride; int K; bool gather;
    __device__ __forceinline__ static int vcu() { const int G = gridDim.x, c = blockIdx.x; return (G % 8 == 0) ? (c % 8) * (G / 8) + c / 8 : c; }
    __device__ __forceinline__ bool next(int i, GUnit& u, LAS unsigned char* lds) const {
        if (i >= 6) return false;
        const i32x4 r = *(const LAS i32x4*)(lds + LM_UT + 16 * i);
        u.e = rfl(r.x); u.T = rfl(r.y); u.pm = rfl(r.z); const int w = rfl(r.w); u.pn = w & 3; u.nai = (w & 4) ? 1 : 2; u.rbase = (w & 8) ? 128 : 0; u.ord = i; return u.e >= 0;
    }
    __device__ __forceinline__ const GAS bf16_t* a_base() const { return A; }
    __device__ __forceinline__ void a_off(const GUnit& u, LAS unsigned char* lds, int tid, unsigned (&off)[2][2]) const {
        const LAS int* ft = (const LAS int*)(lds + LM_FT) + 256 * u.ord;
#pragma unroll
        for (int i = 0; i < 2; ++i) { int R, C; fg::stage_rc(tid * 16 + i * 8192, R, C);
#pragma unroll
            for (int h = 0; h < 2; ++h) { const int rl = u.rbase + (u.nai == 2 ? 128 * h : 0) + R; const int row = gather ? ft[rl] : (256 * u.T + rl); off[h][i] = (unsigned)(row * K + C) * 2u; } }
    }
    __device__ __forceinline__ const GAS bf16_t* b_ptr(const GUnit& u) const { return Bt + (size_t)u.e * bstride + (size_t)256 * u.pn * K; }
};
__device__ __forceinline__ void moe_units(const GAS int* list, bool fill_tok, LAS unsigned char* lds, int wv) {
    const int tid = otid(wv); const LAS int* cnt = (const LAS int*)(lds + LM_CNT); const LAS int* tpre = (const LAS int*)(lds + LM_TPRE);
    LAS int* ft = (LAS int*)(lds + LM_FT); LAS i32x4* ut = (LAS i32x4*)(lds + LM_UT);
    if (tid < 8) {
        const int G = (int)gridDim.x, total = 4 * tpre[32], nfull = (total / G) * G, L = tid * G + FMoe::vcu(); i32x4 r = {-1, 0, 0, 0};
        int idx = L, hb = 0;
        if (L >= nfull) { const int q = L - nfull; idx = nfull + (q >> 1); hb = 4 | ((q & 1) << 3); }
        if (idx < total) { const int T = idx >> 2; int e = 0;
#pragma unroll 8
            for (int k = 1; k < 32; ++k) e += (tpre[k] <= T) ? 1 : 0;
            r = (i32x4){e, T, T - tpre[e], (idx & 3) | hb}; }
        ut[tid] = r;
    }
    __syncthreads();
    if (fill_tok && tid < 256) {
        int tk[5];
#pragma unroll
        for (int i = 0; i < 5; ++i) { const i32x4 r = ut[i]; const int e = r.x < 0 ? 0 : r.x; const int idx = 256 * r.z + tid; tk[i] = (r.x >= 0 && idx < cnt[e]) ? list[e * NTOK + idx] : 0; }
#pragma unroll
        for (int i = 0; i < 5; ++i) ft[256 * i + tid] = tk[i];
    }
    __syncthreads();
}

struct DenseSched {
    const GAS bf16_t* A; int lda; const GAS bf16_t* Bt; int ldb; int nM, nN, nvalid;
    __device__ __forceinline__ bool next(int i, GUnit& u, LAS unsigned char*) const { const int L = i * (int)gridDim.x + (int)blockIdx.x; if (L >= nM * nN) return false; u.pm = L / nN; u.pn = L % nN; u.e = 0; u.T = 0; u.rbase = 0; u.nai = 2; u.ord = i; return true; }
    __device__ __forceinline__ void begin(const GUnit&, LAS unsigned char*) const {}
    __device__ __forceinline__ const GAS bf16_t* a_row(const GUnit& u, int r, LAS unsigned char*) const { return A + (size_t)(256 * u.pm + r) * lda; }
    __device__ __forceinline__ const GAS bf16_t* b_row(const GUnit& u, int r) const { return Bt + (size_t)(256 * u.pn + r) * ldb; }
    __device__ __forceinline__ int b_valid(const GUnit& u) const { return nvalid - 256 * u.pn; }
};
struct EpiQKV {
    const GAS float* rstd1; const GAS float* qkg  ; const GAS f32x2* rope; GAS bf16_t* qkv; GAS unsigned char* vt8;
    __device__ __forceinline__ void operator()(const f32x4 (&acc)[2][2][4][2], const GUnit& u, LAS unsigned char* lds, int wid, int lane) const {
        const int wr = wid >> 2, wc = wid & 3, fr = lane & 15, fq = lane >> 4;
        const int colbase = 256 * u.pn + 64 * wc;
        int mixer = -1, qk = 0;
        if (colbase < COL_KA) { mixer = 0; qk = 0; } else if (colbase < COL_VA) { mixer = 0; qk = 1; } else if (colbase < COL_QB) { mixer = -1; }
        else if (colbase < COL_KB) { mixer = 1; qk = 0; } else if (colbase < COL_VB) { mixer = 1; qk = 1; } else if (colbase < COL_QC) { mixer = -1; }
        else if (colbase < COL_KC) { mixer = 2; qk = 0; } else if (colbase < COL_VC) { mixer = 2; qk = 1; } else { mixer = -1; }
        f32x4 g[2][2];
        if (mixer >= 0) {
#pragma unroll
            for (int bj = 0; bj < 2; ++bj)
#pragma unroll
                for (int n = 0; n < 2; ++n) g[bj][n] = *(const GAS f32x4*)(qkg + (mixer * 2 + qk) * 64 + 32 * bj + (mixer == 2 ? 16 * n + 4 * fq : 8 * fq + 4 * n));
        }
        float rsv[2][4];
#pragma unroll
        for (int ai = 0; ai < 2; ++ai)
#pragma unroll
            for (int m = 0; m < 4; ++m) rsv[ai][m] = rstd1[256 * u.pm + u.rbase + (ai < u.nai ? 128 * ai : 0) + 64 * wr + 16 * m + fr];
        const LAS f32x2* ropeL = (const LAS f32x2*)(lds + L_MISC);
#pragma unroll
        for (int ai = 0; ai < 2; ++ai) {
            if (ai >= u.nai) continue;
            float ssv[4];
            if (mixer >= 0) {
#pragma unroll
                for (int m = 0; m < 4; ++m) { float ss = 0.f;
#pragma unroll
                    for (int bj = 0; bj < 2; ++bj)
#pragma unroll
                        for (int n = 0; n < 2; ++n) { const f32x4 t = acc[ai][bj][m][n]; ss += (t.x * t.x + t.y * t.y) + (t.z * t.z + t.w * t.w); }
                    ssv[m] = ss * rsv[ai][m] * rsv[ai][m]; }
#pragma unroll
                for (int m = 0; m < 4; ++m) ssv[m] += shx(ssv[m], 16, lane);
#pragma unroll
                for (int m = 0; m < 4; ++m) ssv[m] += shx(ssv[m], 32, lane);
            }
#pragma unroll
            for (int m = 0; m < 4; ++m) {
                const int row = 256 * u.pm + u.rbase + 128 * ai + 64 * wr + 16 * m + fr;
                float rs = rsv[ai][m];
                if (mixer >= 0) rs *= __builtin_amdgcn_rsqf(ssv[m] * (1.f / 64.f) + RMS_EPS) * (qk == 0 ? C2 : 1.f);
                f32x4 v[2][2];
#pragma unroll
                for (int bj = 0; bj < 2; ++bj)
#pragma unroll
                    for (int n = 0; n < 2; ++n) v[bj][n] = acc[ai][bj][m][n] * rs;
                if (mixer >= 0) {
#pragma unroll
                    for (int bj = 0; bj < 2; ++bj)
#pragma unroll
                        for (int n = 0; n < 2; ++n) v[bj][n] = v[bj][n] * g[bj][n];
                    if (mixer == 2) {
                        const int t = row & (SEQ - 1);
#pragma unroll
                        for (int bj = 0; bj < 2; ++bj) {
                            const int pos = (bj == 0) ? (t >> 6) : (t & 63);
#pragma unroll
                            for (int i = 0; i < 4; ++i) { const f32x2 cs = ropeL[pos * 16 + 4 * fq + i]; const float x1 = v[bj][0][i], x2 = v[bj][1][i];
                                v[bj][0][i] = x1 * cs.x - x2 * cs.y; v[bj][1][i] = x2 * cs.x + x1 * cs.y; }
                        }
                    }
                }
                if (mixer == 2) {
#pragma unroll
                    for (int bj = 0; bj < 2; ++bj)
#pragma unroll
                        for (int n = 0; n < 2; ++n) { int w = __builtin_amdgcn_cvt_pk_fp8_f32(v[bj][n].x, v[bj][n].y, 0, false); w = __builtin_amdgcn_cvt_pk_fp8_f32(v[bj][n].z, v[bj][n].w, w, true);
                            *(GAS int*)((GAS unsigned char*)qkv + (unsigned)((row * INC + COL_QC) * 2 + (colbase - COL_QC) + 32 * bj + 16 * n + 4 * fq)) = w; }
                } else if (colbase >= COL_VC) {
                    const int tokn = row & (SEQ - 1), key = tokn & 63, pos = ((key & 4) << 3) | ((key & 32) >> 1) | ((key & 24) >> 1) | (key & 3);
                    const unsigned vbase = (unsigned)((((row >> 12) * 2 + ((colbase - COL_VC) >> 6)) * 64) * SEQ + (tokn & ~63) + pos);
#pragma unroll
                    for (int bj = 0; bj < 2; ++bj)
#pragma unroll
                        for (int n = 0; n < 2; ++n) { int w = __builtin_amdgcn_cvt_pk_fp8_f32(v[bj][n].x, v[bj][n].y, 0, false); w = __builtin_amdgcn_cvt_pk_fp8_f32(v[bj][n].z, v[bj][n].w, w, true);
#pragma unroll
                            for (int i = 0; i < 4; ++i) vt8[vbase + (unsigned)((32 * bj + 8 * fq + 4 * n + i) * SEQ)] = (unsigned char)((unsigned)w >> (8 * i)); }
                } else {
#pragma unroll
                    for (int bj = 0; bj < 2; ++bj) { u32x4 o; o.x = pk2(v[bj][0].x, v[bj][0].y); o.y = pk2(v[bj][0].z, v[bj][0].w); o.z = pk2(v[bj][1].x, v[bj][1].y); o.w = pk2(v[bj][1].z, v[bj][1].w);
                        *(GAS u32x4*)(qkv + (unsigned)(row * INC + colbase + 32 * bj + 8 * fq)) = o; }
                }
            }
        }
    }
};
struct EpiWout {
    GAS bf16_t* xb; GAS float* ssqp; GAS unsigned char* x8;
    __device__ __forceinline__ void operator()(const f32x4 (&acc)[2][2][4][2], const GUnit& u, LAS unsigned char*, int wid, int lane) const {
        const int wr = wid >> 2, wc = wid & 3, fr = lane & 15, fq = lane >> 4;
        float ssv[2][4] = {{0.f, 0.f, 0.f, 0.f}, {0.f, 0.f, 0.f, 0.f}};
        u32x4 bx[2][4][2];
#pragma unroll
        for (int ai = 0; ai < 2; ++ai)
#pragma unroll
            for (int m = 0; m < 4; ++m)
#pragma unroll
                for (int bj = 0; bj < 2; ++bj) { const int row = 256 * u.pm + u.rbase + (ai < u.nai ? 128 * ai : 0) + 64 * wr + 16 * m + fr;
                    bx[ai][m][bj] = *(const GAS u32x4*)(xb + (unsigned)(row * DM + 256 * u.pn + 128 * bj + 32 * wc + 8 * fq)); }
#pragma unroll
        for (int ai = 0; ai < 2; ++ai)
#pragma unroll
            for (int m = 0; m < 4; ++m) {
                if (ai >= u.nai) continue;
                const int row = 256 * u.pm + u.rbase + 128 * ai + 64 * wr + 16 * m + fr; float ss = 0.f;
#pragma unroll
                for (int bj = 0; bj < 2; ++bj) { const unsigned off = (unsigned)(row * DM + 256 * u.pn + 128 * bj + 32 * wc + 8 * fq);
                    const u32x4 b = bx[ai][m][bj];
                    const f32x4 x0 = (f32x4){bflo(b.x), bfhi(b.x), bflo(b.y), bfhi(b.y)} + acc[ai][bj][m][0], x1 = (f32x4){bflo(b.z), bfhi(b.z), bflo(b.w), bfhi(b.w)} + acc[ai][bj][m][1];
                    u32x4 o; o.x = pk2(x0.x, x0.y); o.y = pk2(x0.z, x0.w); o.z = pk2(x1.x, x1.y); o.w = pk2(x1.z, x1.w); *(GAS u32x4*)(xb + off) = o;
                    { int w0 = __builtin_amdgcn_cvt_pk_fp8_f32(x0.x, x0.y, 0, false); w0 = __builtin_amdgcn_cvt_pk_fp8_f32(x0.z, x0.w, w0, true);
                      int w1 = __builtin_amdgcn_cvt_pk_fp8_f32(x1.x, x1.y, 0, false); w1 = __builtin_amdgcn_cvt_pk_fp8_f32(x1.z, x1.w, w1, true); *(GAS i32x2*)(x8 + off) = (i32x2){w0, w1}; }
                    ss += (x0.x * x0.x + x0.y * x0.y) + (x0.z * x0.z + x0.w * x0.w) + (x1.x * x1.x + x1.y * x1.y) + (x1.z * x1.z + x1.w * x1.w); }
                ssv[ai][m] = ss;
            }
#pragma unroll
        for (int ai = 0; ai < 2; ++ai)
#pragma unroll
            for (int m = 0; m < 4; ++m) ssv[ai][m] += shx(ssv[ai][m], 16, lane);
#pragma unroll
        for (int ai = 0; ai < 2; ++ai)
#pragma unroll
            for (int m = 0; m < 4; ++m) ssv[ai][m] += shx(ssv[ai][m], 32, lane);
#pragma unroll
        for (int ai = 0; ai < 2; ++ai)
#pragma unroll
            for (int m = 0; m < 4; ++m) { const int row = 256 * u.pm + u.rbase + 128 * ai + 64 * wr + 16 * m + fr; if (ai < u.nai && fq == 0) ssqp[(unsigned)(row * 16 + 4 * u.pn + wc)] = ssv[ai][m]; }
    }
};
__device__ __forceinline__ void p_router(const GArgs& a, int l, LAS unsigned char* lds, int wv) {
    const int tid = otid(wv), lane = tid & 63, wave = rfl(tid >> 6), fr = lane & 15, fq = lane >> 4;
    constexpr int WS_ = 2064, L_W = 0, L_LG = 48 * WS_  ;
    GAS unsigned char* ws = a.ws;
    const GAS bf16_t* xb = (const GAS bf16_t*)(ws + WS_XB); const GAS bf16_t* Wr = (const GAS bf16_t*)(ws + WS_WR) + (size_t)l * 64 * DM;
    const GAS float* ssqp = (const GAS float*)(ws + WS_SSQP); GAS float* rstd2 = (GAS float*)(ws + WS_RSTD2);
    const GAS float* brg = a.in[I_BRG] + l * 4; const GAS float* bre = a.in[I_BRE] + l * 32;
    GAS unsigned* cntg = (GAS unsigned*)(ws + WS_CTL) + CW_CNT + 64 * l;
    GAS int* list = (GAS int*)(ws + WS_LIST); GAS float* glist = (GAS float*)(ws + WS_GLIST); GAS float* rslist = (GAS float*)(ws + WS_RSLIST); GAS int* assign = (GAS int*)(ws + WS_ASSIGN);
    LAS float* lg = (LAS float*)(lds + L_LG); LAS int* rc = (LAS int*)(lds + LM_RC); LAS int* rb = (LAS int*)(lds + LM_RB);
    __syncthreads();
    { u32x4 wv_[12];
#pragma unroll
      for (int i = 0; i < 12; ++i) { const int idx = tid + NTHR * i, row = idx >> 7, ch = idx & 127; const int rc_ = row < 36 ? row : 35;
          wv_[i] = *(const GAS u32x4*)(Wr + (size_t)rc_ * DM + 8 * ch); }
#pragma unroll
      for (int i = 0; i < 12; ++i) { const int idx = tid + NTHR * i, row = idx >> 7, ch = idx & 127; const u32x4 z = {0u, 0u, 0u, 0u};
          *(LAS u32x4*)(lds + L_W + row * WS_ + ch * 16) = row < 36 ? wv_[i] : z; } }
    __syncthreads();
    for (int unit = blockIdx.x; unit < NTOK / 128; unit += gridDim.x) {
        const int row0 = 128 * unit + 16 * wave;
        bf16x8 af[32];
#pragma unroll
        for (int kk = 0; kk < 32; ++kk) af[kk] = *(const GAS bf16x8*)(xb + (size_t)(row0 + fr) * DM + 32 * kk + 8 * fq);
        f32x4 acc[3];
#pragma unroll
        for (int n = 0; n < 3; ++n) acc[n] = (f32x4){0.f, 0.f, 0.f, 0.f};
#pragma unroll
        for (int kk = 0; kk < 32; ++kk)
#pragma unroll
            for (int n = 0; n < 3; ++n) { const bf16x8 bfr = *(const LAS bf16x8*)(lds + L_W + (16 * n + fr) * WS_ + (32 * kk + 8 * fq) * 2); acc[n] = MFMA16(bfr, af[kk], acc[n]); }
#pragma unroll
        for (int n = 0; n < 3; ++n)
#pragma unroll
            for (int i = 0; i < 4; ++i) { const int c = 16 * n + 4 * fq + i; if (c < 36) lg[(16 * wave + fr) * 40 + c] = acc[n][i]; }
        if (tid < 32) rc[tid] = 0;
        __syncthreads();
        int e0 = 0, e1 = 0, r0 = 0, r1 = 0; float g0 = 0.f, g1 = 0.f, rsv = 0.f; const int row = 128 * unit + tid;
        if (tid < 128) {
            float ss = 0.f;
#pragma unroll
            for (int j = 0; j < 4; ++j) { const f32x4 p = *(const GAS f32x4*)(ssqp + (size_t)row * 16 + 4 * j); ss += (p.x + p.y) + (p.z + p.w); }
            const float rs = 1.f / sqrtf(ss * (1.f / DM) + RMS_EPS); rstd2[row] = rs; rsv = rs;
            float gl[4]; int grp = 0;
#pragma unroll
            for (int j = 0; j < 4; ++j) gl[j] = lg[tid * 40 + j] * rs + brg[j];
            float gm = gl[0];
#pragma unroll
            for (int j = 1; j < 4; ++j) if (gl[j] > gm) { gm = gl[j]; grp = j; }
            float den = 0.f;
#pragma unroll
            for (int j = 0; j < 4; ++j) den += __expf(gl[j] - gm);
            const float pgrp = 1.f / den;
            float el[8];
#pragma unroll
            for (int j = 0; j < 8; ++j) el[j] = lg[tid * 40 + 4 + 8 * grp + j] * rs + bre[8 * grp + j];
            int i0 = 0; float v0 = el[0];
#pragma unroll
            for (int j = 1; j < 8; ++j) if (el[j] > v0) { v0 = el[j]; i0 = j; }
            int i1 = -1; float v1 = 0.f;
#pragma unroll
            for (int j = 0; j < 8; ++j) if (j != i0 && (i1 < 0 || el[j] > v1)) { v1 = el[j]; i1 = j; }
            const float ex = __expf(v1 - v0); const float w0 = 1.f / (1.f + ex);
            g0 = pgrp * w0; g1 = pgrp * (ex * w0);
            e0 = 8 * grp + i0; e1 = 8 * grp + i1;
            r0 = __hip_atomic_fetch_add(rc + e0, 1, __ATOMIC_RELAXED, __HIP_MEMORY_SCOPE_WORKGROUP);
            r1 = __hip_atomic_fetch_add(rc + e1, 1, __ATOMIC_RELAXED, __HIP_MEMORY_SCOPE_WORKGROUP);
        }
        __syncthreads();
        if (tid < 32) { const int c = rc[tid]; rb[tid] = c ? (int)__hip_atomic_fetch_add(cntg + tid, (unsigned)c, __ATOMIC_RELAXED, __HIP_MEMORY_SCOPE_AGENT) : 0; }
        __syncthreads();
        if (tid < 128) {
            r0 += rb[e0]; r1 += rb[e1];
            list[e0 * NTOK + r0] = row; glist[e0 * NTOK + r0] = g0; rslist[e0 * NTOK + r0] = rsv;
            list[e1 * NTOK + r1] = row; glist[e1 * NTOK + r1] = g1; rslist[e1 * NTOK + r1] = rsv;
            *(GAS i32x4*)(assign + row * 4) = (i32x4){e0, r0, e1, r1};
        }
        __syncthreads();
    }
}
struct EpiGU {
    const GAS float* rslist; GAS unsigned char* H;
    __device__ __forceinline__ void operator()(const f32x4 (&acc)[2][2][4][2], const GUnit& u, LAS unsigned char* lds, int wid, int lane) const {
        const int wr = wid >> 2, wc = wid & 3, fr = lane & 15, fq = lane >> 4;
        float rsv[2][4];
#pragma unroll
        for (int ai = 0; ai < 2; ++ai)
#pragma unroll
            for (int m = 0; m < 4; ++m) rsv[ai][m] = rslist[(unsigned)(u.e * NTOK + 256 * u.pm + u.rbase + (ai < u.nai ? 128 * ai : 0) + 64 * wr + 16 * m + fr)];
#pragma unroll
        for (int ai = 0; ai < 2; ++ai)
#pragma unroll
            for (int m = 0; m < 4; ++m) {
                if (ai >= u.nai) continue;
                const int rl = u.rbase + 128 * ai + 64 * wr + 16 * m + fr; const float rs = rsv[ai][m];
                f32x4 h[2];
#pragma unroll
                for (int n = 0; n < 2; ++n) { const f32x4 g = acc[ai][0][m][n] * rs, up = acc[ai][1][m][n] * rs;
#pragma unroll
                    for (int i = 0; i < 4; ++i) h[n][i] = g[i] * __builtin_amdgcn_rcpf(1.f + __expf(-g[i])) * up[i]; }
                int w0 = __builtin_amdgcn_cvt_pk_fp8_f32(h[0].x, h[0].y, 0, false); w0 = __builtin_amdgcn_cvt_pk_fp8_f32(h[0].z, h[0].w, w0, true);
                int w1 = __builtin_amdgcn_cvt_pk_fp8_f32(h[1].x, h[1].y, 0, false); w1 = __builtin_amdgcn_cvt_pk_fp8_f32(h[1].z, h[1].w, w1, true);
                *(GAS i32x2*)(H + (unsigned)((256 * u.T + rl) * DE + 128 * u.pn + 32 * wc + 8 * fq)) = (i32x2){w0, w1};
            }
    }
};
struct EpiDown {
    const GAS float* glist; GAS bf16_t* Y;
    __device__ __forceinline__ void operator()(const f32x4 (&acc)[2][2][4][2], const GUnit& u, LAS unsigned char* lds, int wid, int lane) const {
        const int wr = wid >> 2, wc = wid & 3, fr = lane & 15, fq = lane >> 4;
        float gtv[2][4];
#pragma unroll
        for (int ai = 0; ai < 2; ++ai)
#pragma unroll
            for (int m = 0; m < 4; ++m) gtv[ai][m] = glist[(unsigned)(u.e * NTOK + 256 * u.pm + u.rbase + (ai < u.nai ? 128 * ai : 0) + 64 * wr + 16 * m + fr)];
#pragma unroll
        for (int ai = 0; ai < 2; ++ai)
#pragma unroll
            for (int m = 0; m < 4; ++m) {
                if (ai >= u.nai) continue;
                const int rl = u.rbase + 128 * ai + 64 * wr + 16 * m + fr; const float gt = gtv[ai][m];
#pragma unroll
                for (int bj = 0; bj < 2; ++bj) { const f32x4 y0 = acc[ai][bj][m][0] * gt, y1 = acc[ai][bj][m][1] * gt;
                    u32x4 o; o.x = pk2(y0.x, y0.y); o.y = pk2(y0.z, y0.w); o.z = pk2(y1.x, y1.y); o.w = pk2(y1.z, y1.w);
                    *(GAS u32x4*)(Y + (unsigned)((256 * u.T + rl) * DM + 256 * u.pn + 128 * bj + 32 * wc + 8 * fq)) = o; }
            }
    }
};

template <int KS, int VS, class MaskF>
__device__ __forceinline__ void attn_tile32(const bf16x8 (&qf)[4], const LAS char* Kt, const LAS char* Vt, f32x16 (&o)[2], float& lsum, int lane, const MaskF& mf) {
    const int r32 = lane & 31, hi = lane >> 5;
    f32x16 s; float bb[16];
#pragma unroll
    for (int r = 0; r < 16; ++r) { s[r] = 0.f; bb[r] = mf.bias(r, crow(r, hi)); }
#pragma unroll
    for (int d0 = 0; d0 < 4; ++d0) { const bf16x8 kf = *(const LAS bf16x8*)(Kt + r32 * KS + (16 * d0 + 8 * hi) * 2); s = MFMA32(kf, qf[d0], s); }
    float ps = 0.f;
#pragma unroll
    for (int r = 0; r < 16; ++r) { const float p = __builtin_amdgcn_exp2f(s[r] + bb[r]); s[r] = p; ps += p; }
    lsum += ps;
    u32x4 pw0, pw1;
    pw0.x = pk2(s[0], s[1]); pw0.y = pk2(s[2], s[3]); pw0.z = pk2(s[4], s[5]); pw0.w = pk2(s[6], s[7]);
    pw1.x = pk2(s[8], s[9]); pw1.y = pk2(s[10], s[11]); pw1.z = pk2(s[12], s[13]); pw1.w = pk2(s[14], s[15]);
    const LAS char* vb = Vt + (4 * hi + ((lane & 15) >> 2)) * VS + ((lane >> 4) & 1) * 32 + (lane & 3) * 8;
    const int vsw = (((lane & 15) >> 3) & 1) * 64;
    const LAS char* vb0 = vb + vsw; const LAS char* vb1 = vb + (64 ^ vsw);
#pragma unroll
    for (int d0 = 0; d0 < 2; ++d0) {
#pragma unroll
        for (int st = 0; st < 2; ++st) {
            const LAS char* vbd = d0 ? vb1 : vb0; const s16x4 lo = vtr(vbd + (16 * st) * VS), h4 = vtr(vbd + (16 * st + 8) * VS);
            const bf16x8 vf = {lo[0], lo[1], lo[2], lo[3], h4[0], h4[1], h4[2], h4[3]};
            o[d0] = MFMA32(__builtin_bit_cast(bf16x8, st == 0 ? pw0 : pw1), vf, o[d0]);
        }
    }
}
#define SBAR() __builtin_amdgcn_sched_barrier(0)
template <bool HAS_NEXT, bool HAS_PRE, int KS, int VS, class MaskF>
__device__ __forceinline__ void attn_m_step(f32x16& Sc, f32x16& Sn, const bf16x8 (&qf)[4], bf16x8 (&kf)[4], const LAS char* Kpre, const LAS char* Vc, f32x16 (&o)[2], float& lsum, int lane, const MaskF& mf, bool pre_rt = true) {
    const int r32 = lane & 31, hi = lane >> 5;
    float bb[16]; s16x4 vlo[2][2], vhi[2][2];
#pragma unroll
    for (int r = 0; r < 16; ++r) bb[r] = mf.bias(r, crow(r, hi));
    const LAS char* vb = Vc + (4 * hi + ((lane & 15) >> 2)) * VS + ((lane >> 4) & 1) * 32 + (lane & 3) * 8;
    const int vsw = (((lane & 15) >> 3) & 1) * 64;
    const LAS char* vb0 = vb + vsw; const LAS char* vb1 = vb + (64 ^ vsw);
#pragma unroll
    for (int d0 = 0; d0 < 2; ++d0)
#pragma unroll
        for (int st = 0; st < 2; ++st) { const LAS char* vbd = d0 ? vb1 : vb0; vlo[d0][st] = vtr(vbd + (16 * st) * VS); vhi[d0][st] = vtr(vbd + (16 * st + 8) * VS); }
    if (HAS_NEXT) {
#pragma unroll
        for (int r = 0; r < 16; ++r) Sn[r] = 0.f;
    }
    SBAR();
    float ps = 0.f;
#pragma unroll
    for (int g = 0; g < 4; ++g) {
        if (HAS_NEXT) Sn = MFMA32(kf[g], qf[g], Sn);
#pragma unroll
        for (int i = 0; i < 4; ++i) { Sc[4 * g + i] = __builtin_amdgcn_exp2f(Sc[4 * g + i] + bb[4 * g + i]); ps += Sc[4 * g + i]; }
        SBAR();
    }
    lsum += ps;
    if (HAS_PRE && pre_rt) {
#pragma unroll
        for (int d0 = 0; d0 < 4; ++d0) kf[d0] = *(const LAS bf16x8*)(Kpre + r32 * KS + (16 * d0 + 8 * hi) * 2);
    }
    u32x4 pw0, pw1;
    pw0.x = pk2(Sc[0], Sc[1]); pw0.y = pk2(Sc[2], Sc[3]); pw0.z = pk2(Sc[4], Sc[5]); pw0.w = pk2(Sc[6], Sc[7]);
    pw1.x = pk2(Sc[8], Sc[9]); pw1.y = pk2(Sc[10], Sc[11]); pw1.z = pk2(Sc[12], Sc[13]); pw1.w = pk2(Sc[14], Sc[15]);
#pragma unroll
    for (int d0 = 0; d0 < 2; ++d0)
#pragma unroll
        for (int st = 0; st < 2; ++st) {
            const bf16x8 vf = {vlo[d0][st][0], vlo[d0][st][1], vlo[d0][st][2], vlo[d0][st][3], vhi[d0][st][0], vhi[d0][st][1], vhi[d0][st][2], vhi[d0][st][3]};
            o[d0] = MFMA32(__builtin_bit_cast(bf16x8, st == 0 ? pw0 : pw1), vf, o[d0]);
        }
}
template <int KS>
__device__ __forceinline__ void attn_qk_head(f32x16& S, const bf16x8 (&qf)[4], const LAS char* Kt, int lane) {
    const int r32 = lane & 31, hi = lane >> 5;
#pragma unroll
    for (int r = 0; r < 16; ++r) S[r] = 0.f;
#pragma unroll
    for (int d0 = 0; d0 < 4; ++d0) { const bf16x8 k0 = *(const LAS bf16x8*)(Kt + r32 * KS + (16 * d0 + 8 * hi) * 2); S = MFMA32(k0, qf[d0], S); }
}
template <int KS>
__device__ __forceinline__ void attn_kf_load(bf16x8 (&kf)[4], const LAS char* Kt, int lane) {
    const int r32 = lane & 31, hi = lane >> 5;
#pragma unroll
    for (int d0 = 0; d0 < 4; ++d0) kf[d0] = *(const LAS bf16x8*)(Kt + r32 * KS + (16 * d0 + 8 * hi) * 2);
}
struct TokLin { size_t base; __device__ __forceinline__ size_t operator()(int q) const { return base + q; } };
struct TokDil { size_t base; int dil; __device__ __forceinline__ size_t operator()(int q) const { return base + (size_t)dil * q; } };
template <class TokF>
__device__ __forceinline__ void store_o(const f32x16 (&o)[2], float sc, GAS bf16_t* dst, int ld, int lane, const TokF& tokf) {
    const int r32 = lane & 31, hi = lane >> 5;
#pragma unroll
    for (int r = 0; r < 16; ++r) { const int q = crow(r, hi); const float f = shl(sc, q); const size_t off = (size_t)tokf(q) * ld + r32;
        dst[off] = f2bf(o[0][r] * f); dst[off + 32] = f2bf(o[1][r] * f); }
}
__device__ __forceinline__ float gain_bound(const GAS float* g  , int lane) { return wave_max(fabsf(g[lane]), lane) * wave_max(fabsf(g[64 + lane]), lane); }

struct MaskA { const LAS float* tp; int vb;
    __device__ __forceinline__ float bias(int r, int) const { const int c = (r & 3) + 8 * (r >> 2); return ((unsigned)(vb + c) < 16u) ? tp[c] : -INFINITY; } };
__device__ __forceinline__ void p_attn_a(const GArgs& a, int l, LAS unsigned char* lds, int wv) {
    const int tid = otid(wv), lane = tid & 63, wave = rfl(tid >> 6);
    constexpr int KS = 144, VS = 128, L_K = 0, L_V = 512 * KS, L_OACC = L_V + 512 * VS  , L_LACC = L_OACC + 16384, L_TAB = L_LACC + 256;
    static_assert(L_TAB + 7440 <= L_BARW, "LDS map (attention A)");
    const GAS bf16_t* qkv = (const GAS bf16_t*)(a.ws + WS_QKV); GAS bf16_t* oA = (GAS bf16_t*)(a.ws + WS_OBUF + OB_A);
    const GAS float* rpb = a.in[I_RPB] + (size_t)l * 4 * 15 * 31;
    LAS float* tab = (LAS float*)(lds + L_TAB); LAS float* oacc = (LAS float*)(lds + L_OACC); LAS float* lacc = (LAS float*)(lds + L_LACC);
    const int r32 = lane & 31, hi = lane >> 5;
    __syncthreads();
    const float mref = ((const GAS float*)(a.ws + WS_RPBMAX))[4 * l + 0];
    for (int i = tid; i < 1860; i += NTHR) tab[i] = rpb[i] * LOG2E - mref;
    const int qh = wave & 1, kp = wave >> 1;
    const int qc = 32 * qh + r32; int cs = qc - 8; cs = cs < 0 ? 0 : (cs > 48 ? 48 : cs);
    for (int unit = xcd_vcu(); unit < BATCH * 4 * 8; unit += gridDim.x) {
        const int b = unit >> 5, h = (unit >> 3) & 3, rb = unit & 7;
        const size_t tokb = (size_t)b * SEQ;
        const int rfirst = 8 * rb; int r0 = rfirst - 4; r0 = r0 < 0 ? 0 : (r0 > 56 ? 56 : r0);
        lds_barrier();
        { u32x4 kv[8], vv[8];
#pragma unroll
          for (int i = 0; i < 8; ++i) { const int row = 64 * i + (tid >> 3), ch = tid & 7; const size_t tok = tokb + (size_t)(r0 + (row >> 6)) * 64 + (row & 63);
              kv[i] = *(const GAS u32x4*)(qkv + tok * INC + COL_KA + 64 * h + 8 * ch); vv[i] = *(const GAS u32x4*)(qkv + tok * INC + COL_VA + 64 * h + 8 * ch); }
          asm volatile("" : "+v"(kv[0]), "+v"(kv[1]), "+v"(kv[2]), "+v"(kv[3]), "+v"(kv[4]), "+v"(kv[5]), "+v"(kv[6]), "+v"(kv[7]));
          asm volatile("" : "+v"(vv[0]), "+v"(vv[1]), "+v"(vv[2]), "+v"(vv[3]), "+v"(vv[4]), "+v"(vv[5]), "+v"(vv[6]), "+v"(vv[7]));
#pragma unroll
          for (int i = 0; i < 8; ++i) { const int row = 64 * i + (tid >> 3), ch = tid & 7; const int kr = r0 + (row >> 6), slot = kr & 7, kc = row & 63;
              *(LAS u32x4*)(lds + L_K + (slot * 64 + kc) * KS + ch * 16) = kv[i]; *(LAS u32x4*)(lds + L_V + v_off(slot * 64 + kc, ch)) = vv[i]; } }
        bf16x8 qf[4];
#pragma unroll
        for (int d0 = 0; d0 < 4; ++d0) qf[d0] = *(const GAS bf16x8*)(qkv + (tokb + (size_t)rfirst * 64 + 32 * qh + r32) * INC + COL_QA + 64 * h + 16 * d0 + 8 * hi);
        asm volatile("" : "+v"(qf[0]), "+v"(qf[1]), "+v"(qf[2]), "+v"(qf[3]));
#pragma unroll 1
        for (int rr = 0; rr < 8; ++rr) {
            const int r = rfirst + rr;
            int r0n = r + 1 - 4; r0n = r0n < 0 ? 0 : (r0n > 56 ? 56 : r0n);
            const bool slide = (rr < 7) && (r0n > r0);
            lds_barrier();
            u32x4 nk = {0u, 0u, 0u, 0u}, nv = {0u, 0u, 0u, 0u}; bf16x8 qn[4];
            if (slide) { const size_t tok = tokb + (size_t)(r0n + 7) * 64 + (tid >> 3);
                nk = *(const GAS u32x4*)(qkv + tok * INC + COL_KA + 64 * h + 8 * (tid & 7)); nv = *(const GAS u32x4*)(qkv + tok * INC + COL_VA + 64 * h + 8 * (tid & 7)); }
            if (rr < 7) {
#pragma unroll
                for (int d0 = 0; d0 < 4; ++d0) qn[d0] = *(const GAS bf16x8*)(qkv + (tokb + (size_t)(r + 1) * 64 + 32 * qh + r32) * INC + COL_QA + 64 * h + 16 * d0 + 8 * hi);
            }
            f32x16 o[2]; float lsum = 0.f;
#pragma unroll
            for (int r_ = 0; r_ < 16; ++r_) { o[0][r_] = 0.f; o[1][r_] = 0.f; }
            { const int kr0 = r0 + 2 * kp, s0 = kr0 & 7, s1 = (kr0 + 1) & 7;
              const LAS char* K0 = (const LAS char*)(lds + L_K + (s0 * 64) * KS); const LAS char* K1 = (const LAS char*)(lds + L_K + (s1 * 64) * KS);
              const LAS char* V0 = (const LAS char*)(lds + L_V + (s0 * 64) * VS); const LAS char* V1 = (const LAS char*)(lds + L_V + (s1 * 64) * VS);
              const LAS float* t0 = tab + h * 465 + (kr0 - r + 7) * 31 + (4 * hi + 15 - qc); const LAS float* t1 = t0 + 31;
              f32x16 SA, SB; bf16x8 kf[4];
              attn_qk_head<KS>(SA, qf, K0, lane); attn_kf_load<KS>(kf, K0 + 32 * KS, lane);
              { MaskA mf{t0, 4 * hi - cs};      attn_m_step<true, true, KS, VS>(SA, SB, qf, kf, K1, V0, o, lsum, lane, mf); }
              { MaskA mf{t0 + 32, 32 + 4 * hi - cs}; attn_m_step<true, true, KS, VS>(SB, SA, qf, kf, K1 + 32 * KS, V0 + 32 * VS, o, lsum, lane, mf); }
              { MaskA mf{t1, 4 * hi - cs};      attn_m_step<true, false, KS, VS>(SA, SB, qf, kf, K1, V1, o, lsum, lane, mf); }
              { MaskA mf{t1 + 32, 32 + 4 * hi - cs}; attn_m_step<false, false, KS, VS>(SB, SA, qf, kf, K1, V1 + 32 * VS, o, lsum, lane, mf); } }
#pragma unroll 1
            for (int k = 0; k < 4; ++k) {
                if (kp == k) {
                    if (k == 0) {
#pragma unroll
                        for (int r_ = 0; r_ < 16; ++r_) { LAS float* p = oacc + (32 * qh + crow(r_, hi)) * 64 + r32; p[0] = o[0][r_]; p[32] = o[1][r_]; }
                        lsum += shx(lsum, 32, lane);
                        if (hi == 0) lacc[32 * qh + r32] = lsum;
                    } else {
                        float t0[16], t1[16];
#pragma unroll
                        for (int r_ = 0; r_ < 16; ++r_) { const LAS float* p = oacc + (32 * qh + crow(r_, hi)) * 64 + r32; t0[r_] = p[0]; t1[r_] = p[32]; }
                        const float lprev = lacc[32 * qh + r32];
                        lsum += shx(lsum, 32, lane);
                        asm volatile("s_waitcnt lgkmcnt(0)" ::: "memory");
#pragma unroll
                        for (int r_ = 0; r_ < 16; ++r_) { LAS float* p = oacc + (32 * qh + crow(r_, hi)) * 64 + r32; p[0] = t0[r_] + o[0][r_]; p[32] = t1[r_] + o[1][r_]; }
                        if (hi == 0) lacc[32 * qh + r32] = lprev + lsum;
                    }
                }
                lds_barrier();
            }
            asm volatile("" : "+v"(nk), "+v"(nv));
            if (rr < 7) asm volatile("" : "+v"(qn[0]), "+v"(qn[1]), "+v"(qn[2]), "+v"(qn[3]));
            { const int q = tid >> 3, d8 = (tid & 7) * 8; const LAS float* p = oacc + q * 64 + d8;
              const f32x4 v0 = *(const LAS f32x4*)p, v1 = *(const LAS f32x4*)(p + 4); const float inv = 1.f / lacc[q];
              u32x4 w; w.x = pk2(v0.x * inv, v0.y * inv); w.y = pk2(v0.z * inv, v0.w * inv); w.z = pk2(v1.x * inv, v1.y * inv); w.w = pk2(v1.z * inv, v1.w * inv);
              *(GAS u32x4*)(oA + (tokb + (size_t)r * 64 + q) * 256 + 64 * h + d8) = w; }
            if (slide) { const int slot = (r0n + 7) & 7, kc = tid >> 3;
                *(LAS u32x4*)(lds + L_K + (slot * 64 + kc) * KS + (tid & 7) * 16) = nk; *(LAS u32x4*)(lds + L_V + v_off(slot * 64 + kc, tid & 7)) = nv; }
            if (rr < 7) {
#pragma unroll
                for (int d0 = 0; d0 < 4; ++d0) qf[d0] = qn[d0];
            }
            r0 = r0n;
        }
    }
    lds_barrier();
}

struct MaskB { float dlf, slope2, mref; bool chk, rng; int ukey0, L;
    __device__ __forceinline__ float bias(int r, int key) const {
        const float x = dlf + (float)((r & 3) + 8 * (r >> 2)); float b = fmaf(-slope2, fabsf(x), -mref);
        if (chk) b = (fabsf(x) <= 64.f) ? b : -INFINITY;
        if (rng) b = ((unsigned)(ukey0 + key) < (unsigned)L) ? b : -INFINITY;
        return b; } };
struct BUnit { int h, br, dil, L, rho, u0; size_t tokb; };
__device__ __forceinline__ BUnit b_unit(int unit) {
    if (gridDim.x == 256) unit = 192 * ((unit & 255) >> 5) + (unit & 31) + 32 * (unit >> 8);
    BUnit u; const int b = unit / 192, rem = unit % 192, w48 = rem % 48, sub = w48 & 15; u.h = rem / 48; u.br = w48 >> 4;
    u.dil = (u.br == 0) ? 1 : (u.br == 1 ? 4 : 16); u.L = SEQ / u.dil; u.rho = sub % u.dil; u.u0 = 256 * (sub / u.dil); u.tokb = (size_t)b * SEQ; return u;
}
__device__ __forceinline__ void p_attn_b(const GArgs& a, int l, LAS unsigned char* lds, int wv) {
    const int tid = otid(wv), lane = tid & 63, wave = rfl(tid >> 6);
    constexpr int KS = 144, VS = 128, NK = 384, L_K = 0, L_V = NK * KS, L_STG = L_V + NK * VS, NU = BATCH * 4 * 48;
    const GAS bf16_t* qkv = (const GAS bf16_t*)(a.ws + WS_QKV); GAS bf16_t* oB = (GAS bf16_t*)(a.ws + WS_OBUF + OB_B); GAS float* lB = (GAS float*)(a.ws + WS_LB);
    const int r32 = lane & 31, hi = lane >> 5;
    const float mref = ((const GAS float*)(a.ws + WS_RPBMAX))[4 * l + 1];
    u32x4 kv[6], vv[6];
#define B_LOAD(U) do { _Pragma("unroll") for (int i = 0; i < 6; ++i) { const int idx = tid + NTHR * i, row = idx >> 3, ch = idx & 7; const int up = (U).u0 - 64 + row; const int upc = up < 0 ? 0 : (up >= (U).L ? (U).L - 1 : up); \
            const size_t tok = (U).tokb + (size_t)(U).dil * upc + (U).rho; kv[i] = *(const GAS u32x4*)(qkv + tok * INC + COL_KB + 64 * (U).h + 8 * ch); vv[i] = *(const GAS u32x4*)(qkv + tok * INC + COL_VB + 64 * (U).h + 8 * ch); } \
        } while (0)
    int unit = xcd_vcu();
    if (unit < NU) { const BUnit u = b_unit(unit); B_LOAD(u); }
#pragma unroll 1
    for (; unit < NU; unit += gridDim.x) {
        const BUnit u = b_unit(unit);
        const int dil = u.dil, L = u.L, rho = u.rho, u0 = u.u0, h = u.h, br = u.br; const size_t tokb = u.tokb;
        bf16x8 qf[4];
#pragma unroll
        for (int d0 = 0; d0 < 4; ++d0) qf[d0] = *(const GAS bf16x8*)(qkv + (tokb + (size_t)dil * (u0 + 32 * wave + r32) + rho) * INC + COL_QB + 64 * h + 16 * d0 + 8 * hi);
        lds_barrier();
#pragma unroll
        for (int i = 0; i < 6; ++i) { const int idx = tid + NTHR * i, row = idx >> 3, ch = idx & 7; const int up = u0 - 64 + row; const bool ok = (up >= 0) && (up < L);
            const u32x4 z = {0u, 0u, 0u, 0u};
            *(LAS u32x4*)(lds + L_K + row * KS + ch * 16) = ok ? kv[i] : z; *(LAS u32x4*)(lds + L_V + v_off(row, ch)) = ok ? vv[i] : z; }
        asm volatile("" : "+v"(qf[0]), "+v"(qf[1]), "+v"(qf[2]), "+v"(qf[3]));
        lds_barrier();
        if (unit + (int)gridDim.x < NU) { const BUnit un = b_unit(unit + (int)gridDim.x); B_LOAD(un); }
        const int uq = u0 + 32 * wave;
        f32x16 o[2]; float lsum = 0.f;
#pragma unroll
        for (int r_ = 0; r_ < 16; ++r_) { o[0][r_] = 0.f; o[1][r_] = 0.f; }
        const float slope2 = exp2f(-2.f * (float)(h + 1)) * (float)dil * LOG2E;
        { const LAS char* Kw = (const LAS char*)(lds + L_K + 32 * wave * KS); const LAS char* Vw = (const LAS char*)(lds + L_V + 32 * wave * VS);
          const float dl0 = (float)(4 * hi - r32 - 64); const int uk = uq - 64;
          f32x16 SA, SB; bf16x8 kf[4];
          attn_qk_head<KS>(SA, qf, Kw, lane); attn_kf_load<KS>(kf, Kw + 32 * KS, lane);
#define MB(j, chk) MaskB{dl0 + 32.f * (float)(j), slope2, mref, chk, (uk + 32 * (j) < 0) || (uk + 32 * (j) + 31 >= L), uk + 32 * (j), L}
#pragma unroll 1
          for (int jj = 0; jj < 4; jj += 2) {
              { MaskB mf = MB(jj, jj == 0);      attn_m_step<true, true, KS, VS>(SA, SB, qf, kf, Kw + (jj + 2) * 32 * KS, Vw + jj * 32 * VS, o, lsum, lane, mf); }
              { MaskB mf = MB(jj + 1, false);    attn_m_step<true, true, KS, VS>(SB, SA, qf, kf, Kw + (jj + 3) * 32 * KS, Vw + (jj + 1) * 32 * VS, o, lsum, lane, mf, jj == 0); }
          }
          { MaskB mf = MB(4, true);  attn_m_step<false, false, KS, VS>(SA, SB, qf, kf, Kw, Vw + 128 * VS, o, lsum, lane, mf); }
#undef MB
        }
        lsum += shx(lsum, 32, lane);
        {
          LAS bf16_t* stg = (LAS bf16_t*)(lds + L_STG + wave * 4096);
#pragma unroll
          for (int r_ = 0; r_ < 16; ++r_) { const int q = crow(r_, hi); stg[q * 64 + r32] = f2bf(o[0][r_]); stg[q * 64 + 32 + r32] = f2bf(o[1][r_]); }
          asm volatile("s_waitcnt lgkmcnt(0)" ::: "memory");
          GAS bf16_t* ob = oB + (size_t)br * NTOK * 256 + 64 * h;
#pragma unroll
          for (int j = 0; j < 4; ++j) { const int c = lane + 64 * j, q = c >> 3, d8 = (c & 7) * 8; const u32x4 v = *(const LAS u32x4*)(stg + q * 64 + d8);
              *(GAS u32x4*)(ob + (tokb + (size_t)dil * (uq + q) + rho) * 256 + d8) = v; } }
        if (hi == 0) lB[(tokb + (size_t)dil * (uq + r32) + rho) * 16 + 4 * h + br] = lsum;
    }
#undef B_LOAD
}

#define MFMA8(a_, b_, c_) __builtin_amdgcn_mfma_scale_f32_32x32x64_f8f6f4(a_, b_, c_, 0, 0, 0, 0x7F7F7F7F, 0, 0x7F7F7F7F)
constexpr int KS8 = 80;
__device__ __forceinline__ i32x8 kf8_load(const LAS char* Kt, int lane) {
    const int r32 = lane & 31, hi = lane >> 5;
    const i32x4 lo = *(const LAS i32x4*)(Kt + r32 * KS8 + 32 * hi), h4 = *(const LAS i32x4*)(Kt + r32 * KS8 + 32 * hi + 16);
    return (i32x8){lo.x, lo.y, lo.z, lo.w, h4.x, h4.y, h4.z, h4.w};
}
constexpr int VS8 = 144;
__device__ __forceinline__ i32x8 vf8_load(const LAS char* Vt, int lane) {
    const int r32 = lane & 31, hi = lane >> 5;
    const i32x4 lo = *(const LAS i32x4*)(Vt + r32 * VS8 + 32 * hi), h4 = *(const LAS i32x4*)(Vt + r32 * VS8 + 32 * hi + 16);
    return (i32x8){lo.x, lo.y, lo.z, lo.w, h4.x, h4.y, h4.z, h4.w};
}
__device__ __forceinline__ void attn_c_exp(f32x16& Sc, f32x16& lacc, int& p0, int& p1, int& p2, int& p3) {
#pragma unroll
    for (int g = 0; g < 4; ++g) {
#pragma unroll
        for (int i = 0; i < 4; ++i) Sc[4 * g + i] = __builtin_amdgcn_exp2f(Sc[4 * g + i]);
        lacc[0] += Sc[4 * g]; lacc[1] += Sc[4 * g + 1]; lacc[2] += Sc[4 * g + 2]; lacc[3] += Sc[4 * g + 3];
    }
#define PK8(g_) __builtin_amdgcn_cvt_pk_fp8_f32(Sc[4 * (g_) + 2], Sc[4 * (g_) + 3], __builtin_amdgcn_cvt_pk_fp8_f32(Sc[4 * (g_)], Sc[4 * (g_) + 1], 0, false), true)
    p0 = PK8(0); p1 = PK8(1); p2 = PK8(2); p3 = PK8(3);
#undef PK8
}
template <bool NEXT>
__device__ __forceinline__ void attn_c_pair(f32x16& SA, f32x16& SB, const i32x8& qf, i32x8& kf, const LAS char* K2, const LAS char* K3, const LAS char* Vg, f32x16 (&o)[2], f32x16& lacc, const f32x16& negv, int lane) {
    const i32x8 v0 = vf8_load(Vg, lane), v1 = vf8_load(Vg + 32 * VS8, lane);
    SBAR();
    SB = MFMA8(kf, qf, negv);
    int p0, p1, p2, p3, p4, p5, p6, p7;
    attn_c_exp(SA, lacc, p0, p1, p2, p3);
    if (NEXT) kf = kf8_load(K2, lane);
    SBAR();
    if (NEXT) SA = MFMA8(kf, qf, negv);
    attn_c_exp(SB, lacc, p4, p5, p6, p7);
    if (NEXT) kf = kf8_load(K3, lane);
    SBAR();
    const i32x8 pw = {p0, p1, p2, p3, p4, p5, p6, p7};
    o[0] = MFMA8(pw, v0, o[0]); o[1] = MFMA8(pw, v1, o[1]);
}
__device__ __forceinline__ void p_attn_c(const GArgs& a, int l, LAS unsigned char* lds, int wv) {
    const int tid = otid(wv), lane = tid & 63, wave = rfl(tid >> 6);
    constexpr int TK = 128, KB = TK * KS8, VB = 64 * VS8, L_K = 0, L_V = 3 * KB, L_STG = L_V + 3 * VB, NT = SEQ / TK, ROWB = INC * 2, QC8 = COL_QC * 2;
    static_assert(L_STG + 8 * 4096 <= L_BARW, "LDS map (attention C)");
    const GAS unsigned char* qkv8 = (const GAS unsigned char*)(a.ws + WS_QKV); const GAS unsigned char* vt8 = (const GAS unsigned char*)(a.ws + WS_VT8);
    const int r32 = lane & 31, hi = lane >> 5;
    const float negm = -((const GAS float*)(a.ws + WS_RPBMAX))[4 * l + 2];
    f32x16 negv;
#pragma unroll
    for (int r_ = 0; r_ < 16; ++r_) negv[r_] = negm;
    if (wave >= 4) __builtin_amdgcn_s_setprio(1);
    for (int unit = xcd_vcu(); unit < BATCH * 2 * 64; unit += gridDim.x) {
        const int b = unit >> 7, kvh = (unit >> 6) & 1, qb = unit & 63;
        const int head = 4 * kvh + (wave >> 1);
        const size_t tokb = (size_t)b * SEQ, tokq = tokb + 64 * qb + 32 * (wave & 1);
        i32x8 qf;
        { const GAS unsigned char* qp = qkv8 + (tokq + r32) * ROWB + QC8 + 64 * head + 32 * hi; const i32x4 lo = *(const GAS i32x4*)qp, h4 = *(const GAS i32x4*)(qp + 16);
          qf = (i32x8){lo.x, lo.y, lo.z, lo.w, h4.x, h4.y, h4.z, h4.w}; }
        const GAS unsigned char* ksrc = qkv8 + (tokb + (tid >> 2)) * ROWB + QC8 + 512 + 64 * kvh + 16 * (tid & 3);
        const GAS unsigned char* vsrc = vt8 + (size_t)((b * 2 + kvh) * 64 + (tid >> 3)) * SEQ + 16 * (tid & 7);
        const int kdst = L_K + (tid >> 2) * KS8 + (tid & 3) * 16, vdst = L_V + (tid >> 3) * VS8 + (tid & 7) * 16;
        u32x4 rk, rv;
        lds_barrier();
#pragma unroll
        for (int tt = 0; tt < 2; ++tt) {
            rk = *(const GAS u32x4*)(ksrc + (size_t)(tt * TK) * ROWB); rv = *(const GAS u32x4*)(vsrc + tt * TK);
            *(LAS u32x4*)(lds + kdst + tt * KB) = rk; *(LAS u32x4*)(lds + vdst + tt * VB) = rv;
        }
        lds_barrier();
        f32x16 o[2], l2;
#pragma unroll
        for (int r_ = 0; r_ < 16; ++r_) { o[0][r_] = 0.f; o[1][r_] = 0.f; l2[r_] = 0.f; }
        f32x16 SA, SB; i32x8 kf;
        { const i32x8 k0 = kf8_load((const LAS char*)(lds + L_K), lane); SA = MFMA8(k0, qf, negv); }
        kf = kf8_load((const LAS char*)(lds + L_K + 32 * KS8), lane);
        int sc = 0, sn = 1, sw = 2;
        for (int t = 0; t < NT - 1; ++t) {
            if (t + 2 < NT) { rk = *(const GAS u32x4*)(ksrc + (size_t)((t + 2) * TK) * ROWB); rv = *(const GAS u32x4*)(vsrc + (t + 2) * TK); }
            { const LAS char* Kc = (const LAS char*)(lds + L_K + sc * KB); const LAS char* Kn = (const LAS char*)(lds + L_K + sn * KB); const LAS char* Vc = (const LAS char*)(lds + L_V + sc * VB);
              attn_c_pair<true>(SA, SB, qf, kf, Kc + 64 * KS8, Kc + 96 * KS8, Vc, o, l2, negv, lane);
              attn_c_pair<true>(SA, SB, qf, kf, Kn, Kn + 32 * KS8, Vc + 64, o, l2, negv, lane); }
            if (t + 2 < NT) { *(LAS u32x4*)(lds + kdst + sw * KB) = rk; *(LAS u32x4*)(lds + vdst + sw * VB) = rv; }
            lds_barrier();
            const int tmp = sc; sc = sn; sn = sw; sw = tmp;
        }
        { const LAS char* Kc = (const LAS char*)(lds + L_K + sc * KB); const LAS char* Vc = (const LAS char*)(lds + L_V + sc * VB);
          attn_c_pair<true>(SA, SB, qf, kf, Kc + 64 * KS8, Kc + 96 * KS8, Vc, o, l2, negv, lane);
          attn_c_pair<false>(SA, SB, qf, kf, Kc, Kc, Vc + 64, o, l2, negv, lane); }
        {
          LAS bf16_t* stg = (LAS bf16_t*)(lds + L_STG + wave * 4096);
          GAS bf16_t* oCe = (GAS bf16_t*)(oq(a.ws) + WS_OBUF + OB_C);
          float lq = (l2[0] + l2[1]) + (l2[2] + l2[3]); lq += shx(lq, 32, lane); const float linv = 1.f / lq;
#pragma unroll
          for (int r_ = 0; r_ < 16; ++r_) { const int q = crow(r_, hi); const float f = shl(linv, q); stg[q * 64 + r32] = f2bf(o[0][r_] * f); stg[q * 64 + 32 + r32] = f2bf(o[1][r_] * f); }
          asm volatile("s_waitcnt lgkmcnt(0)" ::: "memory");
#pragma unroll
          for (int j = 0; j < 4; ++j) { const int c = lane + 64 * j, q = c >> 3, d8 = (c & 7) * 8; const u32x4 v = *(const LAS u32x4*)(stg + q * 64 + d8);
              *(GAS u32x4*)(oCe + (tokq + q) * 512 + 64 * head + d8) = v; } }
    }
    __builtin_amdgcn_s_setprio(0);
}

__device__ __forceinline__ void p_mixnorm(const GArgs& a, int wv) {
    const int tid_ = otid(wv), lane = tid_ & 63, wave = rfl(tid_ >> 6);
    const GAS bf16_t* oA = (const GAS bf16_t*)(a.ws + WS_OBUF + OB_A); const GAS bf16_t* oC = (const GAS bf16_t*)(a.ws + WS_OBUF + OB_C); const GAS bf16_t* oB = (const GAS bf16_t*)(a.ws + WS_OBUF + OB_B);
    const GAS float* lB = (const GAS float*)(a.ws + WS_LB); GAS bf16_t* mb = (GAS bf16_t*)(a.ws + WS_MB);
    const int gw = blockIdx.x * NWAVES + wave, NGW = gridDim.x * NWAVES;
    constexpr int RB = 4;
    for (int row0 = gw * RB; row0 < NTOK; row0 += NGW * RB) {
        u32x2 wa[RB], wb[RB][3], wc[RB][2]; f32x4 lv[RB];
#pragma unroll
        for (int q = 0; q < RB; ++q) { const size_t row = row0 + q;
            wa[q] = *(const GAS u32x2*)(oA + row * 256 + 4 * lane);
#pragma unroll
            for (int br = 0; br < 3; ++br) wb[q][br] = *(const GAS u32x2*)(oB + ((size_t)br * NTOK + row) * 256 + 4 * lane);
            lv[q] = *(const GAS f32x4*)(lB + row * 16 + 4 * (lane >> 4));
#pragma unroll
            for (int j = 0; j < 2; ++j) wc[q][j] = *(const GAS u32x2*)(oC + row * 512 + 4 * lane + 256 * j); }
#pragma unroll
        for (int q = 0; q < RB; ++q) { const size_t row = row0 + q;
            f32x4 v[4];
            v[0] = (f32x4){bflo(wa[q].x), bfhi(wa[q].x), bflo(wa[q].y), bfhi(wa[q].y)};
            { f32x4 s = {0.f, 0.f, 0.f, 0.f};
#pragma unroll
              for (int br = 0; br < 3; ++br) s += (f32x4){bflo(wb[q][br].x), bfhi(wb[q][br].x), bflo(wb[q][br].y), bfhi(wb[q][br].y)};
              v[1] = s * (1.f / (lv[q].x + lv[q].y + lv[q].z)); }
#pragma unroll
            for (int j = 0; j < 2; ++j) v[2 + j] = (f32x4){bflo(wc[q][j].x), bfhi(wc[q][j].x), bflo(wc[q][j].y), bfhi(wc[q][j].y)};
            float sa = (v[0].x * v[0].x + v[0].y * v[0].y) + (v[0].z * v[0].z + v[0].w * v[0].w);
            float sb = (v[1].x * v[1].x + v[1].y * v[1].y) + (v[1].z * v[1].z + v[1].w * v[1].w);
            float sc = (v[2].x * v[2].x + v[2].y * v[2].y) + (v[2].z * v[2].z + v[2].w * v[2].w) + (v[3].x * v[3].x + v[3].y * v[3].y) + (v[3].z * v[3].z + v[3].w * v[3].w);
            sa = wave_sum(sa, lane); sb = wave_sum(sb, lane); sc = wave_sum(sc, lane);
            const float ra = 1.f / sqrtf(sa * (1.f / 256.f) + RMS_EPS), rb = 1.f / sqrtf(sb * (1.f / 256.f) + RMS_EPS), rc = 1.f / sqrtf(sc * (1.f / 512.f) + RMS_EPS);
            v[0] = v[0] * ra; v[1] = v[1] * rb; v[2] = v[2] * rc; v[3] = v[3] * rc;
#pragma unroll
            for (int j = 0; j < 4; ++j) { u32x2 o; o.x = pk2(v[j].x, v[j].y); o.y = pk2(v[j].z, v[j].w); *(GAS u32x2*)(mb + row * DM + 4 * lane + 256 * j) = o; } }
    }
}

constexpr int PPL = 10, N_PHASES = 2 + PPL * DEPTH;
__global__ void __launch_bounds__(NTHR, 2) fwd(Args a_unused) {
    extern __shared__ __attribute__((aligned(16))) unsigned char lds_raw[];
    LAS unsigned char* lds = (LAS unsigned char*)lds_raw;
    const int wv = rfl((int)threadIdx.x >> 6);
    const int tid = otid(wv);
    int lo, hi; unsigned* barw; { const GArgs a0 = kargs(); barw = (unsigned*)((GAS unsigned*)(a0.ws + WS_CTL) + CW_BAR + a0.li * XCD_BAR_WORDS); lo = a0.ph_lo; hi = a0.ph_hi; }
    if (tid < 16) ((LAS unsigned*)(lds + L_BARW))[tid] = 0u;
    __syncthreads();
    XcdBarrier bar; bar.bar = barw; bar.x = 0; bar.st = nullptr;
    if (hi - lo > 1) bar = xcd_barrier_post(barw, (volatile LAS unsigned*)(lds + L_BARW), tid == 0);
#ifdef PH_ONLY
#define PHSEL(j) ((j) == PH_ONLY)
#else
#define PHSEL(j) true
#endif
#define IN(p) (lo <= (p) && (p) < hi)
#define SEAM(p) do { if ((p) + 1 < hi) xcd_barrier(bar, otid(wv) == 0); } while (0)
#define SOFT(p) do { if ((p) + 1 < hi) __syncthreads(); } while (0)
#define PHASE_ENV const GArgs a = kargs(); GAS unsigned char* ws = a.ws; GAS unsigned* ctl = (GAS unsigned*)(ws + WS_CTL); GAS bf16_t* xb = (GAS bf16_t*)(ws + WS_XB); GAS bf16_t* mbuf = (GAS bf16_t*)(ws + WS_MB); GAS bf16_t* qkv = (GAS bf16_t*)(ws + WS_QKV); (void)ctl; (void)xb; (void)mbuf; (void)qkv

    if (PHSEL(100) && IN(0)) { { PHASE_ENV; p0_prologue(a, lds, wv); } SOFT(0); }
    for (int l = 0; l < DEPTH; ++l) {
        const int pb = 1 + PPL * l;
        if (PHSEL(0) && IN(pb + 0)) { { PHASE_ENV; p_combine(a, l, false, lds, wv); } SEAM(pb + 0); }
        if (PHSEL(1) && IN(pb + 1)) {
            { PHASE_ENV;
            FDense S{xb, (const GAS bf16_t*)(ws + WS_WIN) + (size_t)l * INC * DM, DM, NTOK / 256, INC / 256};
            EpiQKV E{(const GAS float*)(ws + WS_RSTD1), a.in[I_QKG] + (size_t)l * 384, (const GAS f32x2*)(ws + WS_ROPE), qkv, (GAS unsigned char*)(ws + WS_VT8)};
            { const int t_ = otid(wv); const f32x2 r0_ = E.rope[t_], r1_ = E.rope[t_ + NTHR]; LAS f32x2* rl_ = (LAS f32x2*)(lds + L_MISC); rl_[t_] = r0_; rl_[t_ + NTHR] = r1_; }
            gemm_fast<false>(lds, S, E, DM, wv); }
            SEAM(pb + 1);
        }
        if (PHSEL(2) && IN(pb + 2)) { { PHASE_ENV; p_attn_a(a, l, lds, wv); } SOFT(pb + 2); }
        if (PHSEL(3) && IN(pb + 3)) { { PHASE_ENV; p_attn_b(a, l, lds, wv); } SOFT(pb + 3); }
        if (PHSEL(4) && IN(pb + 4)) { { PHASE_ENV; p_attn_c(a, l, lds, wv); } SEAM(pb + 4); }
        if (PHSEL(5) && IN(pb + 5)) { { PHASE_ENV; p_mixnorm(a, wv); } SEAM(pb + 5); }
        if (PHSEL(6) && IN(pb + 6)) {
            { PHASE_ENV;
            FDense S{mbuf, (const GAS bf16_t*)(ws + WS_WOUT) + (size_t)l * DM * DM, DM, NTOK / 256, DM / 256};
            EpiWout E{xb, (GAS float*)(ws + WS_SSQP), (GAS unsigned char*)(ws + WS_X8)};
            gemm_fast<false>(lds, S, E, DM, wv); }
            SEAM(pb + 6);
        }
        if (PHSEL(7) && IN(pb + 7)) { { PHASE_ENV; p_router(a, l, lds, wv); } SEAM(pb + 7); }
        if (PHSEL(8) && IN(pb + 8)) {
            { PHASE_ENV;
            moe_tables(ctl, l, lds, wv);
            FMoe S{(const GAS bf16_t*)(ws + WS_X8), (const GAS bf16_t*)((const GAS unsigned char*)(ws + WS_WGU) + (size_t)l * NE * DM * DM), (size_t)DM * DM / 2, DM / 2, true};
            moe_units((const GAS int*)(ws + WS_LIST), true, lds, wv);
            EpiGU E{(const GAS float*)(ws + WS_RSLIST), (GAS unsigned char*)(ws + WS_OBUF)};
            gemm_fast<true>(lds, S, E, DM / 2, wv); }
            SEAM(pb + 8);
        }
        if (PHSEL(9) && IN(pb + 9)) {
            { PHASE_ENV;
            moe_tables(ctl, l, lds, wv);
            FMoe S{(const GAS bf16_t*)(ws + WS_OBUF), (const GAS bf16_t*)((const GAS unsigned char*)(ws + WS_WD) + (size_t)l * NE * DM * DE), (size_t)DM * DE / 2, DE / 2, false};
            moe_units((const GAS int*)(ws + WS_LIST), false, lds, wv);
            EpiDown E{(const GAS float*)(ws + WS_GLIST), qkv};
            gemm_fast<true>(lds, S, E, DE / 2, wv); }
            SEAM(pb + 9);
        }
    }
    if (PHSEL(101) && IN(N_PHASES - 1)) { PHASE_ENV; p_combine(a, DEPTH, true, lds, wv); }
#undef IN
#undef SEAM
#undef SOFT
}

extern "C" void kernel_launch(void* const* d_in, const int* in_sizes, int n_in, void* d_out, int out_size, void* d_ws, size_t ws_size, hipStream_t stream) {
    static int grid = 0;
    if (grid == 0) {
        if (n_in != 15 || in_sizes[0] != NTOK * DM || out_size != NTOK * DM || ws_size < WS_END) { fprintf(stderr, "kernel_launch: unexpected shapes (n_in %d, in0 %d, out %d, ws %zu)\n", n_in, n_in > 0 ? in_sizes[0] : -1, out_size, ws_size); grid = -1; return; }
        int dev = 0, cus = 0;
        if (hipGetDevice(&dev) != hipSuccess || hipDeviceGetAttribute(&cus, hipDeviceAttributeMultiprocessorCount, dev) != hipSuccess) { grid = -1; return; }
        if (hipFuncSetAttribute((const void*)fwd, hipFuncAttributeMaxDynamicSharedMemorySize, LDS_BYTES) != hipSuccess) { fprintf(stderr, "kernel_launch: hipFuncSetAttribute failed\n"); grid = -1; return; }
        int per_cu = 0;
        if (hipOccupancyMaxActiveBlocksPerMultiprocessor(&per_cu, (const void*)fwd, NTHR, LDS_BYTES) != hipSuccess || per_cu < 1) fprintf(stderr, "kernel_launch: occupancy query reports %d\n", per_cu);
        (void)hipGetLastError();
        grid = cus;
    }
    if (grid < 0) return;
    (void)hipMemsetAsync((char*)d_ws + WS_CTL, 0, CTL_ZERO_BYTES, stream);
    Args a{};
    for (int i = 0; i < 15; ++i) a.in[i] = (const float*)d_in[i];
    a.out = (float*)d_out; a.ws = (unsigned char*)d_ws;
    int li = 0;
    auto launch = [&](int lo, int hi) { a.ph_lo = lo; a.ph_hi = hi; a.li = li++; hipLaunchKernelGGL(fwd, dim3(grid), dim3(NTHR), LDS_BYTES, stream, a); };
#if PROBE_PHASE >= 0
    { int start = 0;
      for (int l = 0; l < DEPTH; ++l) { const int p = 1 + PPL * l + PROBE_PHASE; launch(start, p + 1); launch(p, p + 1); start = p + 1; }
      launch(start, N_PHASES); }
#elif MK_ONE_LAUNCH
    launch(0, N_PHASES);
#else
    for (int p = 0; p < N_PHASES; ++p) launch(p, p + 1);
#endif
}
```

```cpp
#include <hip/hip_runtime.h>
#include <cstdio>
#include <cstdint>

#ifndef PROBE_PHASE
#define PROBE_PHASE -1
#endif
#ifndef MK_ONE_LAUNCH
#define MK_ONE_LAUNCH 1
#endif

#define LAS __attribute__((address_space(3)))
#define GAS __attribute__((address_space(1)))
typedef unsigned short bf16_t;
typedef short bf16x8 __attribute__((ext_vector_type(8)));
typedef short s16x4 __attribute__((ext_vector_type(4)));
typedef short v4i16_t __attribute__((ext_vector_type(4)));
typedef float f32x2 __attribute__((ext_vector_type(2)));
typedef float f32x4 __attribute__((ext_vector_type(4)));
typedef float f32x16 __attribute__((ext_vector_type(16)));
typedef unsigned u32x2 __attribute__((ext_vector_type(2)));
typedef unsigned u32x4 __attribute__((ext_vector_type(4)));
typedef int i32x4 __attribute__((ext_vector_type(4)));
typedef int i32x2 __attribute__((ext_vector_type(2)));
typedef int i32x8 __attribute__((ext_vector_type(8)));
typedef __bf16 bf16x2_t __attribute__((ext_vector_type(2)));

constexpr int NTOK = 32768, DM = 1024, INC = 2304, NE = 32, DE = 512, DEPTH = 4, SEQ = 4096, BATCH = 8;
constexpr int NWAVES = 8, NTHR = 512;
constexpr float RMS_EPS = 1e-6f;
constexpr float LOG2E = 1.4426950408889634f;
constexpr float C2 = 0.125f * LOG2E;
constexpr int COL_QA = 0, COL_KA = 256, COL_VA = 512, COL_QB = 768, COL_KB = 1024, COL_VB = 1280, COL_QC = 1536, COL_KC = 2048, COL_VC = 2176;

constexpr size_t MiB = 1u << 20;
constexpr size_t WS_CTL = 0, CTL_ZERO_BYTES = 1 * MiB;
constexpr size_t WS_WIN = 2 * MiB;
constexpr size_t WS_WOUT = 20 * MiB;
constexpr size_t WS_WR = 28 * MiB;
constexpr size_t WS_ROPE = 29 * MiB;
constexpr size_t WS_RPBMAX = 29 * MiB + 64 * 1024;
constexpr size_t WS_WGU = 32 * MiB;
constexpr size_t WS_WD = 288 * MiB;
constexpr size_t WS_XB = 416 * MiB;
constexpr size_t WS_MB = 480 * MiB;
constexpr size_t WS_QKV = 544 * MiB;
constexpr size_t WS_OBUF = 688 * MiB;
constexpr size_t WS_LB = 784 * MiB;
constexpr size_t WS_RSTD1 = 786 * MiB;
constexpr size_t WS_RSTD2 = WS_RSTD1 + 256 * 1024;
constexpr size_t WS_SSQP = 787 * MiB;
constexpr size_t WS_LIST = 790 * MiB;
constexpr size_t WS_GLIST = 794 * MiB;
constexpr size_t WS_ASSIGN = 798 * MiB;
constexpr size_t WS_RSLIST = 800 * MiB;
constexpr size_t WS_VT8 = 804 * MiB;
constexpr size_t WS_X8 = 808 * MiB;
constexpr size_t WS_END = 840 * MiB;
constexpr size_t OB_A = 0, OB_C = (size_t)NTOK * 256 * 2, OB_B = OB_C + (size_t)NTOK * 512 * 2;
constexpr int CW_CNT = 1024;
constexpr int CW_BAR = 4096;

constexpr int LDS_BYTES = 163840;
constexpr int L_SCR = 0;
constexpr int L_MISC = 139264;
constexpr int L_BARW = LDS_BYTES - 64;

__device__ __forceinline__ int rfl(int v) { return __builtin_amdgcn_readfirstlane(v); }
__device__ __forceinline__ int otid(int wv) { unsigned z = 0u; asm volatile("" : "+v"(z)); return wv * 64 + (int)__builtin_amdgcn_mbcnt_hi(~0u, __builtin_amdgcn_mbcnt_lo(~0u, z)); }
template <class T> __device__ __forceinline__ T* oq(T* p) { asm volatile("" : "+s"(p)); return p; }
__device__ __forceinline__ unsigned pk2(float lo, float hi) { f32x2 v = {lo, hi}; bf16x2_t b = __builtin_convertvector(v, bf16x2_t); return __builtin_bit_cast(unsigned, b); }
__device__ __forceinline__ bf16_t f2bf(float f) { return (bf16_t)(pk2(f, 0.f) & 0xffffu); }
__device__ __forceinline__ float bflo(unsigned w) { return __uint_as_float(w << 16); }
__device__ __forceinline__ float bfhi(unsigned w) { return __uint_as_float(w & 0xffff0000u); }
__device__ __forceinline__ float shx(float v, int m, int lane) { return __int_as_float(__builtin_amdgcn_ds_bpermute((lane ^ m) << 2, __float_as_int(v))); }
__device__ __forceinline__ float shl(float v, int src) { return __int_as_float(__builtin_amdgcn_ds_bpermute(src << 2, __float_as_int(v))); }
__device__ __forceinline__ float wave_sum(float v, int lane) {
#pragma unroll
    for (int o = 1; o < 64; o <<= 1) v += shx(v, o, lane);
    return v;
}
__device__ __forceinline__ float wave_max(float v, int lane) {
#pragma unroll
    for (int o = 1; o < 64; o <<= 1) v = fmaxf(v, shx(v, o, lane));
    return v;
}
__device__ __forceinline__ void lds_barrier() { asm volatile("s_waitcnt lgkmcnt(0)\n\ts_barrier" ::: "memory"); }
__device__ __forceinline__ int xcd_vcu() { const int G = gridDim.x, c = blockIdx.x; return (G % 8 == 0) ? (c % 8) * (G / 8) + c / 8 : c; }
__device__ __forceinline__ int v_off(int row, int ch) { return row * 128 + ((ch ^ (((row >> 1) & 1) << 2)) * 16); }
__device__ __forceinline__ int crow(int r, int hi) { return (r & 3) + 8 * (r >> 2) + 4 * hi; }
#define MFMA32(a, b, c) __builtin_amdgcn_mfma_f32_32x32x16_bf16((a), (b), (c), 0, 0, 0)
#define MFMA16(a, b, c) __builtin_amdgcn_mfma_f32_16x16x32_bf16((a), (b), (c), 0, 0, 0)
__device__ __forceinline__ s16x4 vtr(const LAS char* p) { return __builtin_bit_cast(s16x4, __builtin_amdgcn_ds_read_tr16_b64_v4i16((LAS v4i16_t*)p)); }

#define XB_TMO      128
#define XB_XCNT(j)  (256  + 64 * (j))
#define XB_XSUB(j)  (1280 + 64 * (j))
#define XB_XGEN(j)  (2304 + 64 * (j))
#define XB_TOP      3328
#define XB_TOPGEN   3392
#define XCD_BAR_WORDS 3456
#define XB_SPIN_CAP (1u << 18)
__device__ __forceinline__ unsigned xb_ld(unsigned* p)              { return __hip_atomic_load(p, __ATOMIC_RELAXED, __HIP_MEMORY_SCOPE_AGENT); }
__device__ __forceinline__ unsigned xb_add(unsigned* p, unsigned v) { return __hip_atomic_fetch_add(p, v, __ATOMIC_RELAXED, __HIP_MEMORY_SCOPE_AGENT); }
__device__ __forceinline__ unsigned xb_xcc_id() { return (unsigned)__builtin_amdgcn_s_getreg((3 << 11) | 20) & 0xFu; }
#define XB_SPIN(cond, bar) do { unsigned _sp = 0; while (cond) { __builtin_amdgcn_s_sleep(1); \
    if ((++_sp & 255u) == 0u) { if (xb_ld(&(bar)[XB_TMO])) break; if (_sp > XB_SPIN_CAP) { atomicAdd(&(bar)[XB_TMO], 1u); break; } } } } while (0)
struct XcdBarrier { unsigned* bar; unsigned x; volatile LAS unsigned* st; };
__device__ __forceinline__ XcdBarrier xcd_barrier_post(unsigned* bar, volatile LAS unsigned* st, bool t0) {
    XcdBarrier b; b.bar = bar; b.x = xb_xcc_id(); b.st = st;
    if (t0) (void)xb_add(&bar[XB_XCNT(b.x)], 1u);
    return b;
}
__device__ __forceinline__ void xcd_barrier_complete(unsigned* bar, unsigned x, unsigned& nloc, unsigned& nx) {
    const unsigned G = gridDim.x * gridDim.y * gridDim.z;
    unsigned sum, cnt, mine, sp = 0u;
    for (;;) {
        sum = 0u; cnt = 0u; mine = 0u;
#pragma unroll
        for (unsigned j = 0; j < 16; ++j) { const unsigned c = xb_ld(&bar[XB_XCNT(j)]); sum += c; cnt += (c > 0u) ? 1u : 0u; mine = (j == x) ? c : mine; }
        if (sum == G) break;
        __builtin_amdgcn_s_sleep(1);
        if ((++sp & 255u) == 0u) { if (xb_ld(&bar[XB_TMO])) break; if (sp > XB_SPIN_CAP) { atomicAdd(&bar[XB_TMO], 1u); break; } }
    }
    nloc = mine > 0u ? mine : 1u; nx = cnt > 0u ? cnt : 1u;
}
__device__ __forceinline__ void xcd_barrier(const XcdBarrier& b, bool t0) {
    asm volatile("s_waitcnt vmcnt(0)" ::: "memory");
    __syncthreads();
    if (t0) {
        unsigned* bar = b.bar;
        __builtin_amdgcn_s_waitcnt(0);
        unsigned nloc = b.st[0], nx = b.st[1];
        if (nloc == 0u) { xcd_barrier_complete(bar, b.x, nloc, nx); b.st[0] = nloc; b.st[1] = nx; }
        const unsigned old = xb_add(&bar[XB_XSUB(b.x)], 1u);
        const unsigned gen = old / nloc;
        if (old + 1u == (gen + 1u) * nloc) {
            __builtin_amdgcn_fence(__ATOMIC_RELEASE, "agent");
            asm volatile("s_waitcnt vmcnt(0)" ::: "memory");
            const unsigned og = xb_add(&bar[XB_TOP], 1u);
            const unsigned tg = og / nx;
            if (og + 1u == (tg + 1u) * nx) xb_add(&bar[XB_TOPGEN], 1u);
            else XB_SPIN(xb_ld(&bar[XB_TOPGEN]) == tg, bar);
            __builtin_amdgcn_fence(__ATOMIC_ACQUIRE, "agent");
            xb_add(&bar[XB_XGEN(b.x)], 1u);
            asm volatile("s_waitcnt vmcnt(0)" ::: "memory");
        } else {
            XB_SPIN(xb_ld(&bar[XB_XGEN(b.x)]) == gen, bar);
            __builtin_amdgcn_fence(__ATOMIC_ACQUIRE, "agent");
            asm volatile("s_waitcnt vmcnt(0)" ::: "memory");
        }
    }
    __syncthreads();
}

struct Args { const float* in[15]; float* out; unsigned char* ws; int ph_lo, ph_hi, li, pad; };
struct GArgs { const GAS float* in[15]; GAS float* out; GAS unsigned char* ws; int ph_lo, ph_hi, li, pad; };
__device__ __forceinline__ GArgs kargs() {
    GArgs r;
#if defined(__HIP_DEVICE_COMPILE__)
    typedef const __attribute__((address_space(4))) unsigned long long* CU64P;
    CU64P p = (CU64P)__builtin_amdgcn_kernarg_segment_ptr(); asm volatile("" : "+s"(p));
    unsigned long long* d = (unsigned long long*)&r;
#pragma unroll
    for (int i = 0; i < (int)(sizeof(Args) / 8); ++i) d[i] = p[i];
#endif
    return r;
}
enum { I_X = 0, I_N1G, I_WIN, I_QKG, I_RPB, I_MIXG, I_WOUT, I_N2G, I_WRG, I_BRG, I_WRE, I_BRE, I_WG, I_WU, I_WDN };

__device__ __forceinline__ int slot32(int j) { return 16 * ((j >> 2) & 1) + 4 * (j >> 3) + (j & 3); }
__device__ __forceinline__ int destrow(int mode, int c) {
    if (mode == 1) { const int j = c & 31; const bool rope = (c >= COL_QC) && (c < COL_VC);
        return (c & ~255) + ((c >> 5) & 1) * 128 + ((c >> 6) & 3) * 32 + (rope ? j : slot32(j)); }
    if (mode == 2) return 256 * (c >> 7) + (c & 96) + slot32(c & 31);
    if (mode == 3) return 256 * (c >> 7) + 128 + (c & 96) + slot32(c & 31);
    return (c & ~31) + slot32(c & 31);
}
template <bool F8>
__device__ __forceinline__ void tp_item(const GAS float* W, int K, int N, GAS bf16_t* WT, const GAS float* kscale, int mode, LAS float* scr, int item, int lane) {
    const int nblk = N / 32, kb = item / nblk, nb = item % nblk, k0 = 64 * kb, n0 = 32 * nb;
    float wv_[32];
#pragma unroll
    for (int i = 0; i < 32; ++i) wv_[i] = W[(size_t)(k0 + 2 * i + (lane >> 5)) * N + n0 + (lane & 31)];
#pragma unroll
    for (int i = 0; i < 32; ++i) { const int kk = 2 * i + (lane >> 5); const float s = kscale ? kscale[k0 + kk] : 1.f; scr[kk * 33 + (lane & 31)] = wv_[i] * s; }
    asm volatile("s_waitcnt lgkmcnt(0)" ::: "memory");
    if (F8) {
        const int c = lane & 3;
#pragma unroll
        for (int j = 0; j < 2; ++j) { const int n = (lane >> 2) + 16 * j; const LAS float* s = scr + (16 * c) * 33 + n;
            int w[4];
#pragma unroll
            for (int q = 0; q < 4; ++q) { w[q] = __builtin_amdgcn_cvt_pk_fp8_f32(s[(4 * q) * 33] * 64.f, s[(4 * q + 1) * 33] * 64.f, 0, false); w[q] = __builtin_amdgcn_cvt_pk_fp8_f32(s[(4 * q + 2) * 33] * 64.f, s[(4 * q + 3) * 33] * 64.f, w[q], true); }
            *(GAS i32x4*)((GAS unsigned char*)WT + (size_t)destrow(mode, n0 + n) * K + k0 + 16 * c) = (i32x4){w[0], w[1], w[2], w[3]}; }
    } else {
        const int c = lane & 7;
#pragma unroll
        for (int j = 0; j < 4; ++j) { const int n = (lane >> 3) + 8 * j; const LAS float* s = scr + (8 * c) * 33 + n;
            u32x4 o; o.x = pk2(s[0 * 33], s[1 * 33]); o.y = pk2(s[2 * 33], s[3 * 33]); o.z = pk2(s[4 * 33], s[5 * 33]); o.w = pk2(s[6 * 33], s[7 * 33]);
            *(GAS u32x4*)(WT + (size_t)destrow(mode, n0 + n) * K + k0 + 8 * c) = o; }
    }
    asm volatile("s_waitcnt lgkmcnt(0)" ::: "memory");
}
__device__ __forceinline__ void p0_prologue(const GArgs& a, LAS unsigned char* lds, int wv) {
    const int tid_ = otid(wv), lane = tid_ & 63, wave = rfl(tid_ >> 6);
    LAS float* scr = (LAS float*)(lds + wave * 16384);
    const int gw = blockIdx.x * NWAVES + wave, NGW = gridDim.x * NWAVES;
    GAS unsigned char* ws = a.ws;
    constexpr int I_IN = 16 * 72, I_OUT = 16 * 32, I_E = 256, PER_L = I_IN + I_OUT + NE * 3 * I_E;
    for (int it = gw; it < DEPTH * PER_L; it += NGW) {
        const int l = it / PER_L; int r = it % PER_L;
        if (r < I_IN) { tp_item<false>(a.in[I_WIN] + (size_t)l * DM * INC, DM, INC, (GAS bf16_t*)(ws + WS_WIN) + (size_t)l * INC * DM, a.in[I_N1G] + l * DM, 1, scr, r, lane); continue; } r -= I_IN;
        if (r < I_OUT) { tp_item<false>(a.in[I_WOUT] + (size_t)l * DM * DM, DM, DM, (GAS bf16_t*)(ws + WS_WOUT) + (size_t)l * DM * DM, a.in[I_MIXG] + l * DM, 0, scr, r, lane); continue; } r -= I_OUT;
        const int e = r / (3 * I_E), rr = r % (3 * I_E), which = rr / I_E, item = rr % I_E; const size_t le = (size_t)l * NE + e;
        if (which == 0)      tp_item<true>(a.in[I_WG] + le * DM * DE, DM, DE, (GAS bf16_t*)((GAS unsigned char*)(ws + WS_WGU) + le * DM * DM), a.in[I_N2G] + l * DM, 2, scr, item, lane);
        else if (which == 1) tp_item<true>(a.in[I_WU] + le * DM * DE, DM, DE, (GAS bf16_t*)((GAS unsigned char*)(ws + WS_WGU) + le * DM * DM), a.in[I_N2G] + l * DM, 3, scr, item, lane);
        else                 tp_item<true>(a.in[I_WDN] + le * DE * DM, DE, DM, (GAS bf16_t*)((GAS unsigned char*)(ws + WS_WD) + le * DM * DE), nullptr, 0, scr, item, lane);
    }
    const int gt = blockIdx.x * NTHR + tid_, NGT = gridDim.x * NTHR;
    for (int idx = gt; idx < DEPTH * 36 * DM; idx += NGT) {
        const int l = idx / (36 * DM), n = (idx / DM) % 36, k = idx % DM;
        const float w = (n < 4) ? a.in[I_WRG][((size_t)l * DM + k) * 4 + n] : a.in[I_WRE][((size_t)l * DM + k) * 32 + (n - 4)];
        ((GAS bf16_t*)(ws + WS_WR))[((size_t)l * 64 + n) * DM + k] = f2bf(w * a.in[I_N2G][l * DM + k]);
    }
    if (wave == 0 && blockIdx.x < DEPTH) { const GAS float* rp = a.in[I_RPB] + (size_t)blockIdx.x * 1860; float mx = 0.f;
        for (int i = lane; i < 1860; i += 64) mx = fmaxf(mx, fabsf(rp[i]));
        mx = wave_max(mx, lane);
        const GAS float* qg = a.in[I_QKG] + (size_t)blockIdx.x * 384;
        const float ba = wave_max(fabsf(qg[lane]), lane) * wave_max(fabsf(qg[64 + lane]), lane), bb_ = wave_max(fabsf(qg[128 + lane]), lane) * wave_max(fabsf(qg[192 + lane]), lane),
                    bc = wave_max(fabsf(qg[256 + lane]), lane) * wave_max(fabsf(qg[320 + lane]), lane);
        const float gqc = qg[256 + lane], gkc = qg[320 + lane]; const float sigc = LOG2E * sqrtf(wave_sum(gqc * gqc * gkc * gkc, lane) * (1.f / 64.f));
        if (lane == 0) { GAS float* mr = (GAS float*)(ws + WS_RPBMAX) + 4 * blockIdx.x; mr[0] = (8.f * ba + mx) * LOG2E; mr[1] = 8.f * bb_ * LOG2E; mr[2] = fminf(9.f * sigc, 1.15f * 8.f * bc * LOG2E) - 8.75f; mr[3] = mx; } }
    if (gt < 64 * 16) {
        const int pos = gt >> 4, f = gt & 15;
        double inv = 1.0; for (int i = 0; i < f; ++i) inv *= 0.56234132519034908;
        const float invf = (float)inv; const float angf = (float)pos * invf;
        const double x = (double)angf;
        const double kq = __builtin_rint(x * 0.63661977236758134);
        const double rr = (x - kq * 1.5707963267341256) - kq * 6.0771005065061922e-11;
        const double r2 = rr * rr;
        double sn = rr * (1.0 + r2 * (-1.0 / 6 + r2 * (1.0 / 120 + r2 * (-1.0 / 5040 + r2 * (1.0 / 362880 + r2 * (-1.0 / 39916800 + r2 * (1.0 / 6227020800.0)))))));
        double cs = 1.0 + r2 * (-0.5 + r2 * (1.0 / 24 + r2 * (-1.0 / 720 + r2 * (1.0 / 40320 + r2 * (-1.0 / 3628800 + r2 * (1.0 / 479001600.0 + r2 * (-1.0 / 87178291200.0)))))));
        const int q = ((int)kq) & 3; double c, s;
        if (q == 0) { c = cs; s = sn; } else if (q == 1) { c = -sn; s = cs; } else if (q == 2) { c = -cs; s = -sn; } else { c = sn; s = -cs; }
        ((GAS f32x2*)(ws + WS_ROPE))[gt] = (f32x2){(float)c, (float)s};
    }
}

constexpr int LM_CNT = L_MISC, LM_TPRE = L_MISC + 128, LM_TOKL = L_MISC + 512, LM_GL = L_MISC + 512 + 1024, LM_RC = L_MISC + 512 + 2048, LM_RB = LM_RC + 128;
__device__ __forceinline__ void moe_tables(const GAS unsigned* ctl, int l, LAS unsigned char* lds, int wv) {
    LAS int* cnt = (LAS int*)(lds + LM_CNT); LAS int* tpre = (LAS int*)(lds + LM_TPRE);
    const int tid = otid(wv);
    __syncthreads();
    if (tid < 32) cnt[tid] = (int)__hip_atomic_load(ctl + CW_CNT + 64 * l + tid, __ATOMIC_RELAXED, __HIP_MEMORY_SCOPE_AGENT);
    __syncthreads();
    if (tid < 64) {
        const int lane = tid; int v = (lane < 32) ? ((cnt[lane & 31] + 255) >> 8) : 0; const int own = v;
#pragma unroll
        for (int o = 1; o < 32; o <<= 1) { const int t = __builtin_amdgcn_ds_bpermute(((lane - o) & 63) << 2, v); if (lane >= o) v += t; }
        if (lane < 32) tpre[lane] = v - own;
        if (lane == 31) tpre[32] = v;
    }
    __syncthreads();
}

__device__ __forceinline__ void p_combine(const GArgs& a, int l, bool final_, LAS unsigned char* lds, int wv) {
    const int tid_ = otid(wv), lane = tid_ & 63, wave = rfl(tid_ >> 6);
    GAS unsigned char* ws = oq(a.ws);
    const bool comb = (l > 0);
    const GAS unsigned char* Y8 = (const GAS unsigned char*)(ws + WS_QKV);
    const GAS int* assign = (const GAS int*)(ws + WS_ASSIGN);
    GAS bf16_t* xb = (GAS bf16_t*)(ws + WS_XB); GAS float* rstd1 = (GAS float*)(ws + WS_RSTD1);
    if (comb) moe_tables((const GAS unsigned*)(ws + WS_CTL), l - 1, lds, wv);
    const LAS int* tpre = (const LAS int*)(lds + LM_TPRE);
    const int gw = blockIdx.x * NWAVES + wave, NGW = gridDim.x * NWAVES;
    constexpr int RB = 4;
    for (int row0 = gw * RB; row0 < NTOK; row0 += NGW * RB) {
        float v[RB][16];
        if (!comb) {
            f32x4 xi[RB][4];
#pragma unroll
            for (int q = 0; q < RB; ++q)
#pragma unroll
                for (int j = 0; j < 4; ++j) xi[q][j] = *(const GAS f32x4*)(a.in[I_X] + (size_t)(row0 + q) * DM + 16 * lane + 4 * j);
#pragma unroll
            for (int q = 0; q < RB; ++q)
#pragma unroll
                for (int j = 0; j < 4; ++j) { v[q][4 * j] = xi[q][j].x; v[q][4 * j + 1] = xi[q][j].y; v[q][4 * j + 2] = xi[q][j].z; v[q][4 * j + 3] = xi[q][j].w; }
        } else {
            i32x4 as[RB]; u32x4 x0[RB][2]; i32x4 y0[RB], y1[RB];
#pragma unroll
            for (int q = 0; q < RB; ++q) as[q] = *(const GAS i32x4*)(assign + (row0 + q) * 4);
#pragma unroll
            for (int q = 0; q < RB; ++q)
#pragma unroll
                for (int j = 0; j < 2; ++j) x0[q][j] = *(const GAS u32x4*)(xb + (size_t)(row0 + q) * DM + 16 * lane + 8 * j);
#pragma unroll
            for (int q = 0; q < RB; ++q) { const size_t s0 = (size_t)tpre[as[q].x] * 256 + as[q].y, s1 = (size_t)tpre[as[q].z] * 256 + as[q].w;
                y0[q] = *(const GAS i32x4*)(Y8 + s0 * DM + 16 * lane); y1[q] = *(const GAS i32x4*)(Y8 + s1 * DM + 16 * lane); }
#pragma unroll
            for (int q = 0; q < RB; ++q) {
#pragma unroll
                for (int j = 0; j < 2; ++j) { const u32x4 b = x0[q][j];
                    v[q][8 * j] = bflo(b.x); v[q][8 * j + 1] = bfhi(b.x); v[q][8 * j + 2] = bflo(b.y); v[q][8 * j + 3] = bfhi(b.y); v[q][8 * j + 4] = bflo(b.z); v[q][8 * j + 5] = bfhi(b.z); v[q][8 * j + 6] = bflo(b.w); v[q][8 * j + 7] = bfhi(b.w); }
#pragma unroll
                for (int d = 0; d < 4; ++d) { const int w0 = y0[q][d], w1 = y1[q][d];
                    const f32x2 a0 = __builtin_amdgcn_cvt_pk_f32_fp8(w0, false), a1 = __builtin_amdgcn_cvt_pk_f32_fp8(w0, true), b0 = __builtin_amdgcn_cvt_pk_f32_fp8(w1, false), b1 = __builtin_amdgcn_cvt_pk_f32_fp8(w1, true);
                    v[q][4 * d] += (a0.x + b0.x) * (1.f / 16.f); v[q][4 * d + 1] += (a0.y + b0.y) * (1.f / 16.f); v[q][4 * d + 2] += (a1.x + b1.x) * (1.f / 16.f); v[q][4 * d + 3] += (a1.y + b1.y) * (1.f / 16.f); }
            }
        }
#pragma unroll
        for (int q = 0; q < RB; ++q) {
            const int row = row0 + q;
            if (final_) {
#pragma unroll
                for (int j = 0; j < 4; ++j) *(GAS f32x4*)(a.out + (size_t)row * DM + 16 * lane + 4 * j) = (f32x4){v[q][4 * j], v[q][4 * j + 1], v[q][4 * j + 2], v[q][4 * j + 3]};
            } else {
                float s = 0.f;
#pragma unroll
                for (int j = 0; j < 16; ++j) s += v[q][j] * v[q][j];
                s = wave_sum(s, lane);
                if (lane == 0) rstd1[row] = 1.f / sqrtf(s * (1.f / DM) + RMS_EPS);
#pragma unroll
                for (int j = 0; j < 2; ++j) { u32x4 o; o.x = pk2(v[q][8 * j], v[q][8 * j + 1]); o.y = pk2(v[q][8 * j + 2], v[q][8 * j + 3]); o.z = pk2(v[q][8 * j + 4], v[q][8 * j + 5]); o.w = pk2(v[q][8 * j + 6], v[q][8 * j + 7]);
                    *(GAS u32x4*)(xb + (size_t)row * DM + 16 * lane + 8 * j) = o; }
            }
        }
    }
}

struct GUnit { int pm, pn, e, T, rbase, nai, ord; };
constexpr int G_AS = 0, G_BS = 20480, G_ROWB = 80;
template <class Sched, class Epi>
__device__ __forceinline__ void gemm_simple(LAS unsigned char* lds, const Sched& S, const Epi& E, const int K, int wv) {
    const int tid = otid(wv), wid = rfl(tid >> 6), lane = tid & 63, wr = wid >> 2, wc = wid & 3, fr = lane & 15, fq = lane >> 4;
    GUnit u;
    for (int ui = 0; S.next(ui, u, lds); ++ui) {
        S.begin(u, lds);
        const GAS bf16_t* ap[2]; const GAS bf16_t* bp[2]; bool bv[2];
        const int nbv = S.b_valid(u);
#pragma unroll
        for (int i = 0; i < 2; ++i) { const int r = (tid >> 2) + 128 * i; ap[i] = S.a_row(u, r, lds) + (tid & 3) * 8; bp[i] = S.b_row(u, r) + (tid & 3) * 8; bv[i] = r < nbv; }
        f32x4 acc[2][2][4][2];
#pragma unroll
        for (int x = 0; x < 2; ++x)
#pragma unroll
            for (int y = 0; y < 2; ++y)
#pragma unroll
                for (int m = 0; m < 4; ++m)
#pragma unroll
                    for (int n = 0; n < 2; ++n) acc[x][y][m][n] = (f32x4){0.f, 0.f, 0.f, 0.f};
        for (int kt = 0; kt < K / 32; ++kt) {
            u32x4 ra[2], rb[2];
#pragma unroll
            for (int i = 0; i < 2; ++i) { ra[i] = *(const GAS u32x4*)(ap[i] + kt * 32); rb[i] = bv[i] ? *(const GAS u32x4*)(bp[i] + kt * 32) : (u32x4){0u, 0u, 0u, 0u}; }
            __syncthreads();
#pragma unroll
            for (int i = 0; i < 2; ++i) { const int r = (tid >> 2) + 128 * i;
                *(LAS u32x4*)(lds + G_AS + r * G_ROWB + (tid & 3) * 16) = ra[i];
                *(LAS u32x4*)(lds + G_BS + r * G_ROWB + (tid & 3) * 16) = rb[i]; }
            __syncthreads();
#pragma unroll
            for (int ai = 0; ai < 2; ++ai) {
                bf16x8 At[4];
#pragma unroll
                for (int m = 0; m < 4; ++m) At[m] = *(const LAS bf16x8*)(lds + G_AS + (128 * ai + 64 * wr + 16 * m + fr) * G_ROWB + 16 * fq);
#pragma unroll
                for (int bj = 0; bj < 2; ++bj) {
                    bf16x8 Bt[2];
#pragma unroll
                    for (int n = 0; n < 2; ++n) Bt[n] = *(const LAS bf16x8*)(lds + G_BS + (128 * bj + 32 * wc + 16 * n + fr) * G_ROWB + 16 * fq);
#pragma unroll
                    for (int m = 0; m < 4; ++m)
#pragma unroll
                        for (int n = 0; n < 2; ++n) acc[ai][bj][m][n] = MFMA16(Bt[n], At[m], acc[ai][bj][m][n]);
                }
            }
        }
        E(acc, u, lds, wid, lane);
    }
}

namespace fg {
constexpr int BK = 64, HALF = 128, HTB = HALF * BK * 2;
__device__ __forceinline__ int lds_byte(int r, int c) { const int st = (r >> 4) * 2 + (c >> 5), rr = r & 15, cc = c & 31, ob = rr * 64 + cc * 2; return st * 1024 + (ob ^ (((ob >> 9) & 1) << 5)); }
__device__ __forceinline__ void stage_rc(int b, int& R, int& C) { const int st = b / 1024, sb = b % 1024, swz = sb ^ (((sb >> 9) & 1) << 5); R = (st >> 1) * 16 + swz / 64; C = (st & 1) * 32 + (swz % 64) / 2; }
}
template <bool F8, class Sched, class Epi>
__device__ __forceinline__ void gemm_fast(LAS unsigned char* lds, const Sched& S, const Epi& E, const int K, int wv) {
    using namespace fg;
    const int tid = otid(wv), wid = rfl(tid >> 6), lane = tid & 63, wr = wid >> 2, wc = wid & 3, fr = lane & 15, fq = lane >> 4;
    int nt = K / BK; asm volatile("" : "+s"(nt));
    unsigned voffB[2];
#pragma unroll
    for (int i = 0; i < 2; ++i) { int R_, C_; stage_rc(tid * 16 + i * 8192, R_, C_); voffB[i] = (unsigned)(R_ * K + C_) * 2u; }
    const size_t kstep = (size_t)(BK * 2), hstep = (size_t)HALF * K * 2;
    const unsigned ldsw = (unsigned)wid * 1024u;
    const int aoff = lds_byte(wr * 64 + fr, fq * 8), boff = lds_byte(wc * 32 + fr, fq * 8);
#define FG_SA(b, h) (((b) * 2 + (h)) * HTB)
#define FG_SB(b, h) ((4 + (b) * 2 + (h)) * HTB)
#define FG_STAGE(bufoff, gbase, voff) do { _Pragma("unroll") for (int _i = 0; _i < 2; ++_i) \
        __builtin_amdgcn_global_load_lds((const GAS unsigned*)((const GAS char*)(gbase) + (voff)[_i]), (LAS unsigned*)(lds + (bufoff) + ldsw + _i * 8192), 16, 0, 0); } while (0)
#define FG_LDA(dst, b, h) do { _Pragma("unroll") for (int m = 0; m < 4; ++m) _Pragma("unroll") for (int k = 0; k < 2; ++k) dst[m][k] = *(const LAS bf16x8*)(lds + FG_SA(b, h) + aoff + m * 2048 + k * 1024); } while (0)
#define FG_LDB(dst, b, h) do { _Pragma("unroll") for (int n = 0; n < 2; ++n) _Pragma("unroll") for (int k = 0; k < 2; ++k) dst[n][k] = *(const LAS bf16x8*)(lds + FG_SB(b, h) + boff + n * 2048 + k * 1024); } while (0)
#define FG_L8(p_) __builtin_shufflevector(*(const LAS i32x4*)(p_), *(const LAS i32x4*)((p_) + 1024), 0, 1, 2, 3, 4, 5, 6, 7)
#define FG_LDA8(dst, b, h) do { _Pragma("unroll") for (int m = 0; m < 4; ++m) dst[m] = FG_L8(lds + FG_SA(b, h) + aoff + m * 2048); } while (0)
#define FG_LDB8(dst, b, h) do { _Pragma("unroll") for (int n = 0; n < 2; ++n) dst[n] = FG_L8(lds + FG_SB(b, h) + boff + n * 2048); } while (0)
#define FG_MMA8(ai, bj, At_, Bt_) do { __builtin_amdgcn_s_setprio(1); _Pragma("unroll") for (int m = 0; m < 4; ++m) _Pragma("unroll") for (int n = 0; n < 2; ++n) \
        asm volatile("v_mfma_scale_f32_16x16x128_f8f6f4 %0, %1, %2, %0, %3, %4 op_sel_hi:[0,0,0]" : "+v"(acc[ai][bj][m][n]) : "v"(Bt_[n]), "v"(At_[m]), "v"(sclw), "v"(scla)); __builtin_amdgcn_s_setprio(0); } while (0)
#define FG_MMA(ai, bj, At, Bt) do { __builtin_amdgcn_s_setprio(1); _Pragma("unroll") for (int m = 0; m < 4; ++m) _Pragma("unroll") for (int n = 0; n < 2; ++n) _Pragma("unroll") for (int k = 0; k < 2; ++k) \
        acc[ai][bj][m][n] = MFMA16(Bt[n][k], At[m][k], acc[ai][bj][m][n]); __builtin_amdgcn_s_setprio(0); } while (0)
#define FG_WAIT_V(n) asm volatile("s_waitcnt vmcnt(" #n ")" ::: "memory")
#define FG_WAIT_L(n) asm volatile("s_waitcnt lgkmcnt(" #n ")" ::: "memory")
#define FG_BAR __builtin_amdgcn_s_barrier()
#define FG_SCHED __builtin_amdgcn_sched_barrier(0)
    GUnit cur, nxt; int ui = 0;
    if (!S.next(0, cur, lds)) return;
    f32x4 acc[2][2][4][2];
#pragma unroll
    for (int x = 0; x < 2; ++x)
#pragma unroll
        for (int y = 0; y < 2; ++y)
#pragma unroll
            for (int m = 0; m < 4; ++m)
#pragma unroll
                for (int n = 0; n < 2; ++n) acc[x][y][m][n] = (f32x4){0.f, 0.f, 0.f, 0.f};
    bf16x8 At[4][2], B0[2][2], B1[2][2];
    i32x8 A8[4], B80[2], B81[2];
    int sclw = 0x79797979, scla = 0x7F7F7F7F; asm volatile("" : "+v"(sclw), "+v"(scla));
    const GAS char* Ab = (const GAS char*)S.a_base();
    unsigned vc[2][2];
    S.a_off(cur, lds, tid, vc);
    const GAS char* cB = (const GAS char*)S.b_ptr(cur);
    FG_STAGE(FG_SB(0, 0), cB, voffB); FG_STAGE(FG_SB(0, 1), cB + hstep, voffB); FG_STAGE(FG_SA(0, 0), Ab, vc[0]); FG_STAGE(FG_SA(0, 1), Ab, vc[1]);
    if (wr == 1) FG_BAR;
    FG_WAIT_V(2); FG_BAR;
    FG_STAGE(FG_SB(1, 0), cB + kstep, voffB); FG_STAGE(FG_SA(1, 0), Ab + kstep, vc[0]); FG_STAGE(FG_SB(1, 1), cB + hstep + kstep, voffB);
    FG_WAIT_V(6); FG_BAR;
    for (;;) {
        const bool has_next = S.next(ui + 1, nxt, lds);
        const GAS char* nB = has_next ? (const GAS char*)S.b_ptr(nxt) : cB;
        const bool full = cur.nai == 2;
#pragma unroll 1
        for (int t = 0; t < nt; t += 2) {
            const bool last = (t == nt - 2);
            const GAS char* a1 = Ab + (size_t)(t + 1) * kstep;
            const GAS char* a2 = last ? Ab : Ab + (size_t)(t + 2) * kstep; const GAS char* b2 = last ? nB : cB + (size_t)(t + 2) * kstep;
            const GAS char* a3 = a2 + kstep; const GAS char* b3 = b2 + kstep;
            const unsigned va1[2] = {vc[1][0], vc[1][1]};
            if (last && has_next) S.a_off(nxt, lds, tid, vc);
#define FG_XLDB(b_) do { if (F8) { FG_LDB8(B80, b_, 0); FG_LDB8(B81, b_, 1); } else { FG_LDB(B0, b_, 0); FG_LDB(B1, b_, 1); } } while (0)
#define FG_XLDA(b_, h_) do { if (F8) FG_LDA8(A8, b_, h_); else FG_LDA(At, b_, h_); } while (0)
#define FG_XMMA(ai_) do { if (F8) { FG_MMA8(ai_, 0, A8, B80); FG_MMA8(ai_, 1, A8, B81); } else { FG_MMA(ai_, 0, At, B0); FG_MMA(ai_, 1, At, B1); } } while (0)
            FG_XLDB(0); FG_SCHED; FG_XLDA(0, 0); FG_STAGE(FG_SA(1, 1), a1, va1);
            FG_WAIT_V(8); FG_WAIT_L(0); FG_BAR; FG_XMMA(0); FG_BAR; FG_SCHED;
            FG_XLDA(0, 1); FG_STAGE(FG_SB(0, 0), b2, voffB); FG_STAGE(FG_SB(0, 1), b2 + hstep, voffB); FG_STAGE(FG_SA(0, 0), a2, vc[0]);
            FG_WAIT_V(8); FG_WAIT_L(0); FG_BAR; if (full) { FG_XMMA(1); } FG_BAR; FG_SCHED;
            FG_XLDB(1); FG_SCHED; FG_XLDA(1, 0); FG_STAGE(FG_SA(0, 1), a2, vc[1]);
            FG_WAIT_V(8); FG_WAIT_L(0); FG_BAR; FG_XMMA(0); FG_BAR; FG_SCHED;
            FG_XLDA(1, 1); FG_STAGE(FG_SB(1, 0), b3, voffB); FG_STAGE(FG_SB(1, 1), b3 + hstep, voffB); FG_STAGE(FG_SA(1, 0), a3, vc[0]);
            FG_WAIT_V(8); FG_WAIT_L(0); FG_BAR; if (full) { FG_XMMA(1); } FG_BAR; FG_SCHED;
#undef FG_XLDB
#undef FG_XLDA
#undef FG_XMMA
        }
        if (wr == 0) FG_BAR;
        if (F8) { asm volatile("s_nop 15\n\ts_nop 15\n\ts_nop 15" ::: "memory"); }
        E(acc, cur, lds, wid, lane);
        if (!has_next) break;
#pragma unroll
        for (int x = 0; x < 2; ++x)
#pragma unroll
            for (int y = 0; y < 2; ++y)
#pragma unroll
                for (int m = 0; m < 4; ++m)
#pragma unroll
                    for (int n = 0; n < 2; ++n) acc[x][y][m][n] = (f32x4){0.f, 0.f, 0.f, 0.f};
        cur = nxt; cB = nB; ++ui;
        if (wr == 1) FG_BAR;
    }
    FG_WAIT_V(0);
    FG_BAR;
#undef FG_SA
#undef FG_SB
#undef FG_STAGE
#undef FG_LDA
#undef FG_LDB
#undef FG_MMA
#undef FG_L8
#undef FG_LDA8
#undef FG_LDB8
#undef FG_MMA8
#undef FG_WAIT_V
#undef FG_WAIT_L
#undef FG_BAR
#undef FG_SCHED
}
struct FDense {
    const GAS bf16_t* A; const GAS bf16_t* Bt; int K, nM, nN;
    __device__ __forceinline__ bool next(int i, GUnit& u, LAS unsigned char*) const {
        const int nwg = nM * nN, G = (int)gridDim.x, nfull = (nwg / G) * G; const int L = i * G + (int)blockIdx.x;
        int wgid = L; u.rbase = 0; u.nai = 2; u.ord = i;
        if (L >= nfull) { const int r = L - nfull; wgid = nfull + (r >> 1); if (wgid >= nwg) return false; u.rbase = 128 * (r & 1); u.nai = 1; }
        { const int q = nwg / 8, r = nwg % 8, xcd = wgid % 8, off = wgid / 8; wgid = (xcd < r ? xcd * (q + 1) : r * (q + 1) + (xcd - r) * q) + off; }
        const int nig = 8 * nN, gid = wgid / nig, fm = gid * 8, gsz = (nM - fm) < 8 ? (nM - fm) : 8;
        u.pm = fm + ((wgid % nig) % gsz); u.pn = (wgid % nig) / gsz; u.e = 0; u.T = 0; return true;
    }
    __device__ __forceinline__ const GAS bf16_t* a_base() const { return A; }
    __device__ __forceinline__ void a_off(const GUnit& u, LAS unsigned char*, int tid, unsigned (&off)[2][2]) const {
#pragma unroll
        for (int i = 0; i < 2; ++i) { int R, C; fg::stage_rc(tid * 16 + i * 8192, R, C);
#pragma unroll
            for (int h = 0; h < 2; ++h) off[h][i] = (unsigned)((256 * u.pm + u.rbase + (u.nai == 2 ? 128 * h : 0) + R) * K + C) * 2u; }
    }
    __device__ __forceinline__ const GAS bf16_t* b_ptr(const GUnit& u) const { return Bt + (size_t)256 * u.pn * K; }
};
constexpr int LM_FT = L_MISC + 512;
constexpr int LM_UT = L_MISC + 512 + 5120;
struct FMoe {
    const GAS bf16_t* A; const GAS bf16_t* Bt; size_t bstride; int K; bool gather;
    __device__ __forceinline__ static int vcu() { const int G = gridDim.x, c = blockIdx.x; return (G % 8 == 0) ? (c % 8) * (G / 8) + c / 8 : c; }
    __device__ __forceinline__ bool next(int i, GUnit& u, LAS unsigned char* lds) const {
        if (i >= 6) return false;
        const i32x4 r = *(const LAS i32x4*)(lds + LM_UT + 16 * i);
        u.e = rfl(r.x); u.T = rfl(r.y); u.pm = rfl(r.z); const int w = rfl(r.w); u.pn = w & 3; u.nai = (w & 4) ? 1 : 2; u.rbase = (w & 8) ? 128 : 0; u.ord = i; return u.e >= 0;
    }
    __device__ __forceinline__ const GAS bf16_t* a_base() const { return A; }
    __device__ __forceinline__ void a_off(const GUnit& u, LAS unsigned char* lds, int tid, unsigned (&off)[2][2]) const {
        const LAS int* ft = (const LAS int*)(lds + LM_FT) + 256 * u.ord;
#pragma unroll
        for (int i = 0; i < 2; ++i) { int R, C; fg::stage_rc(tid * 16 + i * 8192, R, C);
#pragma unroll
            for (int h = 0; h < 2; ++h) { const int rl = u.rbase + (u.nai == 2 ? 128 * h : 0) + R; const int row = gather ? ft[rl] : (256 * u.T + rl); off[h][i] = (unsigned)(row * K + C) * 2u; } }
    }
    __device__ __forceinline__ const GAS bf16_t* b_ptr(const GUnit& u) const { return Bt + (size_t)u.e * bstride + (size_t)256 * u.pn * K; }
};
constexpr int LM_RS = L_MISC + 6144;
__device__ __forceinline__ void moe_units(const GAS int* list, bool fill_tok, const GAS float* rowsc, LAS unsigned char* lds, int wv) {
    const int tid = otid(wv); const LAS int* cnt = (const LAS int*)(lds + LM_CNT); const LAS int* tpre = (const LAS int*)(lds + LM_TPRE);
    LAS int* ft = (LAS int*)(lds + LM_FT); LAS i32x4* ut = (LAS i32x4*)(lds + LM_UT);
    if (tid < 8) {
        const int G = (int)gridDim.x, total = 4 * tpre[32], nfull = (total / G) * G, L = tid * G + FMoe::vcu(); i32x4 r = {-1, 0, 0, 0};
        int idx = L, hb = 0;
        if (L >= nfull) { const int q = L - nfull; idx = nfull + (q >> 1); hb = 4 | ((q & 1) << 3); }
        if (idx < total) { const int T = idx >> 2; int e = 0;
#pragma unroll 8
            for (int k = 1; k < 32; ++k) e += (tpre[k] <= T) ? 1 : 0;
            r = (i32x4){e, T, T - tpre[e], (idx & 3) | hb}; }
        ut[tid] = r;
    }
    __syncthreads();
    if (fill_tok && tid < 256) {
        int tk[5];
#pragma unroll
        for (int i = 0; i < 5; ++i) { const i32x4 r = ut[i]; const int e = r.x < 0 ? 0 : r.x; const int idx = 256 * r.z + tid; tk[i] = (r.x >= 0 && idx < cnt[e]) ? list[e * NTOK + idx] : 0; }
#pragma unroll
        for (int i = 0; i < 5; ++i) ft[256 * i + tid] = tk[i];
    }
    if (tid >= 256) {
        const int t2 = tid - 256; float rv[5]; LAS float* rsl = (LAS float*)(lds + LM_RS);
#pragma unroll
        for (int i = 0; i < 5; ++i) { const i32x4 r = ut[i]; const int e = r.x < 0 ? 0 : r.x; const int idx = 256 * r.z + t2; rv[i] = (r.x >= 0 && idx < cnt[e]) ? rowsc[e * NTOK + idx] : 0.f; }
#pragma unroll
        for (int i = 0; i < 5; ++i) rsl[256 * i + t2] = rv[i];
    }
    __syncthreads();
}

struct DenseSched {
    const GAS bf16_t* A; int lda; const GAS bf16_t* Bt; int ldb; int nM, nN, nvalid;
    __device__ __forceinline__ bool next(int i, GUnit& u, LAS unsigned char*) const { const int L = i * (int)gridDim.x + (int)blockIdx.x; if (L >= nM * nN) return false; u.pm = L / nN; u.pn = L % nN; u.e = 0; u.T = 0; u.rbase = 0; u.nai = 2; u.ord = i; return true; }
    __device__ __forceinline__ void begin(const GUnit&, LAS unsigned char*) const {}
    __device__ __forceinline__ const GAS bf16_t* a_row(const GUnit& u, int r, LAS unsigned char*) const { return A + (size_t)(256 * u.pm + r) * lda; }
    __device__ __forceinline__ const GAS bf16_t* b_row(const GUnit& u, int r) const { return Bt + (size_t)(256 * u.pn + r) * ldb; }
    __device__ __forceinline__ int b_valid(const GUnit& u) const { return nvalid - 256 * u.pn; }
};
struct EpiQKV {
    const GAS float* rstd1; const GAS float* qkg  ; const GAS f32x2* rope; GAS bf16_t* qkv; GAS unsigned char* vt8;
    __device__ __forceinline__ void operator()(const f32x4 (&acc)[2][2][4][2], const GUnit& u, LAS unsigned char* lds, int wid, int lane) const {
        const int wr = wid >> 2, wc = wid & 3, fr = lane & 15, fq = lane >> 4;
        const int colbase = 256 * u.pn + 64 * wc;
        int mixer = -1, qk = 0;
        if (colbase < COL_KA) { mixer = 0; qk = 0; } else if (colbase < COL_VA) { mixer = 0; qk = 1; } else if (colbase < COL_QB) { mixer = -1; }
        else if (colbase < COL_KB) { mixer = 1; qk = 0; } else if (colbase < COL_VB) { mixer = 1; qk = 1; } else if (colbase < COL_QC) { mixer = -1; }
        else if (colbase < COL_KC) { mixer = 2; qk = 0; } else if (colbase < COL_VC) { mixer = 2; qk = 1; } else { mixer = -1; }
        f32x4 g[2][2];
        if (mixer >= 0) {
#pragma unroll
            for (int bj = 0; bj < 2; ++bj)
#pragma unroll
                for (int n = 0; n < 2; ++n) g[bj][n] = *(const GAS f32x4*)(qkg + (mixer * 2 + qk) * 64 + 32 * bj + (mixer == 2 ? 16 * n + 4 * fq : 8 * fq + 4 * n));
        }
        float rsv[2][4];
#pragma unroll
        for (int ai = 0; ai < 2; ++ai)
#pragma unroll
            for (int m = 0; m < 4; ++m) rsv[ai][m] = rstd1[256 * u.pm + u.rbase + (ai < u.nai ? 128 * ai : 0) + 64 * wr + 16 * m + fr];
        const LAS f32x2* ropeL = (const LAS f32x2*)(lds + L_MISC);
#pragma unroll
        for (int ai = 0; ai < 2; ++ai) {
            if (ai >= u.nai) continue;
            float ssv[4];
            if (mixer >= 0) {
#pragma unroll
                for (int m = 0; m < 4; ++m) { float ss = 0.f;
#pragma unroll
                    for (int bj = 0; bj < 2; ++bj)
#pragma unroll
                        for (int n = 0; n < 2; ++n) { const f32x4 t = acc[ai][bj][m][n]; ss += (t.x * t.x + t.y * t.y) + (t.z * t.z + t.w * t.w); }
                    ssv[m] = ss * rsv[ai][m] * rsv[ai][m]; }
#pragma unroll
                for (int m = 0; m < 4; ++m) ssv[m] += shx(ssv[m], 16, lane);
#pragma unroll
                for (int m = 0; m < 4; ++m) ssv[m] += shx(ssv[m], 32, lane);
            }
#pragma unroll
            for (int m = 0; m < 4; ++m) {
                const int row = 256 * u.pm + u.rbase + 128 * ai + 64 * wr + 16 * m + fr;
                float rs = rsv[ai][m];
                if (mixer >= 0) rs *= __builtin_amdgcn_rsqf(ssv[m] * (1.f / 64.f) + RMS_EPS) * (qk == 0 ? C2 : 1.f);
                f32x4 v[2][2];
#pragma unroll
                for (int bj = 0; bj < 2; ++bj)
#pragma unroll
                    for (int n = 0; n < 2; ++n) v[bj][n] = acc[ai][bj][m][n] * rs;
                if (mixer >= 0) {
#pragma unroll
                    for (int bj = 0; bj < 2; ++bj)
#pragma unroll
                        for (int n = 0; n < 2; ++n) v[bj][n] = v[bj][n] * g[bj][n];
                    if (mixer == 2) {
                        const int t = row & (SEQ - 1);
#pragma unroll
                        for (int bj = 0; bj < 2; ++bj) {
                            const int pos = (bj == 0) ? (t >> 6) : (t & 63);
#pragma unroll
                            for (int i = 0; i < 4; ++i) { const f32x2 cs = ropeL[pos * 16 + 4 * fq + i]; const float x1 = v[bj][0][i], x2 = v[bj][1][i];
                                v[bj][0][i] = x1 * cs.x - x2 * cs.y; v[bj][1][i] = x2 * cs.x + x1 * cs.y; }
                        }
                    }
                }
                if (mixer == 2) {
#pragma unroll
                    for (int bj = 0; bj < 2; ++bj)
#pragma unroll
                        for (int n = 0; n < 2; ++n) { int w = __builtin_amdgcn_cvt_pk_fp8_f32(v[bj][n].x, v[bj][n].y, 0, false); w = __builtin_amdgcn_cvt_pk_fp8_f32(v[bj][n].z, v[bj][n].w, w, true);
                            *(GAS int*)((GAS unsigned char*)qkv + (unsigned)((row * INC + COL_QC) * 2 + (colbase - COL_QC) + 32 * bj + 16 * n + 4 * fq)) = w; }
                } else if (colbase >= COL_VC) {
                    const int tokn = row & (SEQ - 1), key = tokn & 63, pos = ((key & 4) << 3) | ((key & 32) >> 1) | ((key & 24) >> 1) | (key & 3);
                    const unsigned vbase = (unsigned)((((row >> 12) * 2 + ((colbase - COL_VC) >> 6)) * 64) * SEQ + (tokn & ~63) + pos);
#pragma unroll
                    for (int bj = 0; bj < 2; ++bj)
#pragma unroll
                        for (int n = 0; n < 2; ++n) { int w = __builtin_amdgcn_cvt_pk_fp8_f32(v[bj][n].x, v[bj][n].y, 0, false); w = __builtin_amdgcn_cvt_pk_fp8_f32(v[bj][n].z, v[bj][n].w, w, true);
#pragma unroll
                            for (int i = 0; i < 4; ++i) vt8[vbase + (unsigned)((32 * bj + 8 * fq + 4 * n + i) * SEQ)] = (unsigned char)((unsigned)w >> (8 * i)); }
                } else {
#pragma unroll
                    for (int bj = 0; bj < 2; ++bj) { u32x4 o; o.x = pk2(v[bj][0].x, v[bj][0].y); o.y = pk2(v[bj][0].z, v[bj][0].w); o.z = pk2(v[bj][1].x, v[bj][1].y); o.w = pk2(v[bj][1].z, v[bj][1].w);
                        *(GAS u32x4*)(qkv + (unsigned)(row * INC + colbase + 32 * bj + 8 * fq)) = o; }
                }
            }
        }
    }
};
struct EpiWout {
    GAS bf16_t* xb; GAS float* ssqp; GAS unsigned char* x8;
    __device__ __forceinline__ void operator()(const f32x4 (&acc)[2][2][4][2], const GUnit& u, LAS unsigned char*, int wid, int lane) const {
        const int wr = wid >> 2, wc = wid & 3, fr = lane & 15, fq = lane >> 4;
        float ssv[2][4] = {{0.f, 0.f, 0.f, 0.f}, {0.f, 0.f, 0.f, 0.f}};
        u32x4 bx[2][4][2];
#pragma unroll
        for (int ai = 0; ai < 2; ++ai)
#pragma unroll
            for (int m = 0; m < 4; ++m)
#pragma unroll
                for (int bj = 0; bj < 2; ++bj) { const int row = 256 * u.pm + u.rbase + (ai < u.nai ? 128 * ai : 0) + 64 * wr + 16 * m + fr;
                    bx[ai][m][bj] = *(const GAS u32x4*)(xb + (unsigned)(row * DM + 256 * u.pn + 128 * bj + 32 * wc + 8 * fq)); }
#pragma unroll
        for (int ai = 0; ai < 2; ++ai)
#pragma unroll
            for (int m = 0; m < 4; ++m) {
                if (ai >= u.nai) continue;
                const int row = 256 * u.pm + u.rbase + 128 * ai + 64 * wr + 16 * m + fr; float ss = 0.f;
#pragma unroll
                for (int bj = 0; bj < 2; ++bj) { const unsigned off = (unsigned)(row * DM + 256 * u.pn + 128 * bj + 32 * wc + 8 * fq);
                    const u32x4 b = bx[ai][m][bj];
                    const f32x4 x0 = (f32x4){bflo(b.x), bfhi(b.x), bflo(b.y), bfhi(b.y)} + acc[ai][bj][m][0], x1 = (f32x4){bflo(b.z), bfhi(b.z), bflo(b.w), bfhi(b.w)} + acc[ai][bj][m][1];
                    u32x4 o; o.x = pk2(x0.x, x0.y); o.y = pk2(x0.z, x0.w); o.z = pk2(x1.x, x1.y); o.w = pk2(x1.z, x1.w); *(GAS u32x4*)(xb + off) = o;
                    { int w0 = __builtin_amdgcn_cvt_pk_fp8_f32(x0.x, x0.y, 0, false); w0 = __builtin_amdgcn_cvt_pk_fp8_f32(x0.z, x0.w, w0, true);
                      int w1 = __builtin_amdgcn_cvt_pk_fp8_f32(x1.x, x1.y, 0, false); w1 = __builtin_amdgcn_cvt_pk_fp8_f32(x1.z, x1.w, w1, true); *(GAS i32x2*)(x8 + off) = (i32x2){w0, w1}; }
                    ss += (x0.x * x0.x + x0.y * x0.y) + (x0.z * x0.z + x0.w * x0.w) + (x1.x * x1.x + x1.y * x1.y) + (x1.z * x1.z + x1.w * x1.w); }
                ssv[ai][m] = ss;
            }
#pragma unroll
        for (int ai = 0; ai < 2; ++ai)
#pragma unroll
            for (int m = 0; m < 4; ++m) ssv[ai][m] += shx(ssv[ai][m], 16, lane);
#pragma unroll
        for (int ai = 0; ai < 2; ++ai)
#pragma unroll
            for (int m = 0; m < 4; ++m) ssv[ai][m] += shx(ssv[ai][m], 32, lane);
#pragma unroll
        for (int ai = 0; ai < 2; ++ai)
#pragma unroll
            for (int m = 0; m < 4; ++m) { const int row = 256 * u.pm + u.rbase + 128 * ai + 64 * wr + 16 * m + fr; if (ai < u.nai && fq == 0) ssqp[(unsigned)(row * 16 + 4 * u.pn + wc)] = ssv[ai][m]; }
    }
};
__device__ __forceinline__ void p_router(const GArgs& a, int l, LAS unsigned char* lds, int wv) {
    const int tid = otid(wv), lane = tid & 63, wave = rfl(tid >> 6), fr = lane & 15, fq = lane >> 4;
    constexpr int WS_ = 2064, L_W = 0, L_LG = 48 * WS_  ;
    GAS unsigned char* ws = a.ws;
    const GAS bf16_t* xb = (const GAS bf16_t*)(ws + WS_XB); const GAS bf16_t* Wr = (const GAS bf16_t*)(ws + WS_WR) + (size_t)l * 64 * DM;
    const GAS float* ssqp = (const GAS float*)(ws + WS_SSQP); GAS float* rstd2 = (GAS float*)(ws + WS_RSTD2);
    const GAS float* brg = a.in[I_BRG] + l * 4; const GAS float* bre = a.in[I_BRE] + l * 32;
    GAS unsigned* cntg = (GAS unsigned*)(ws + WS_CTL) + CW_CNT + 64 * l;
    GAS int* list = (GAS int*)(ws + WS_LIST); GAS float* glist = (GAS float*)(ws + WS_GLIST); GAS float* rslist = (GAS float*)(ws + WS_RSLIST); GAS int* assign = (GAS int*)(ws + WS_ASSIGN);
    LAS float* lg = (LAS float*)(lds + L_LG); LAS int* rc = (LAS int*)(lds + LM_RC); LAS int* rb = (LAS int*)(lds + LM_RB);
    __syncthreads();
    { u32x4 wv_[12];
#pragma unroll
      for (int i = 0; i < 12; ++i) { const int idx = tid + NTHR * i, row = idx >> 7, ch = idx & 127; const int rc_ = row < 36 ? row : 35;
          wv_[i] = *(const GAS u32x4*)(Wr + (size_t)rc_ * DM + 8 * ch); }
#pragma unroll
      for (int i = 0; i < 12; ++i) { const int idx = tid + NTHR * i, row = idx >> 7, ch = idx & 127; const u32x4 z = {0u, 0u, 0u, 0u};
          *(LAS u32x4*)(lds + L_W + row * WS_ + ch * 16) = row < 36 ? wv_[i] : z; } }
    __syncthreads();
    for (int unit = blockIdx.x; unit < NTOK / 128; unit += gridDim.x) {
        const int row0 = 128 * unit + 16 * wave;
        bf16x8 af[32];
#pragma unroll
        for (int kk = 0; kk < 32; ++kk) af[kk] = *(const GAS bf16x8*)(xb + (size_t)(row0 + fr) * DM + 32 * kk + 8 * fq);
        f32x4 acc[3];
#pragma unroll
        for (int n = 0; n < 3; ++n) acc[n] = (f32x4){0.f, 0.f, 0.f, 0.f};
#pragma unroll
        for (int kk = 0; kk < 32; ++kk)
#pragma unroll
            for (int n = 0; n < 3; ++n) { const bf16x8 bfr = *(const LAS bf16x8*)(lds + L_W + (16 * n + fr) * WS_ + (32 * kk + 8 * fq) * 2); acc[n] = MFMA16(bfr, af[kk], acc[n]); }
#pragma unroll
        for (int n = 0; n < 3; ++n)
#pragma unroll
            for (int i = 0; i < 4; ++i) { const int c = 16 * n + 4 * fq + i; if (c < 36) lg[(16 * wave + fr) * 40 + c] = acc[n][i]; }
        if (tid < 32) rc[tid] = 0;
        __syncthreads();
        int e0 = 0, e1 = 0, r0 = 0, r1 = 0; float g0 = 0.f, g1 = 0.f, rsv = 0.f; const int row = 128 * unit + tid;
        if (tid < 128) {
            float ss = 0.f;
#pragma unroll
            for (int j = 0; j < 4; ++j) { const f32x4 p = *(const GAS f32x4*)(ssqp + (size_t)row * 16 + 4 * j); ss += (p.x + p.y) + (p.z + p.w); }
            const float rs = 1.f / sqrtf(ss * (1.f / DM) + RMS_EPS); rstd2[row] = rs; rsv = rs;
            float gl[4]; int grp = 0;
#pragma unroll
            for (int j = 0; j < 4; ++j) gl[j] = lg[tid * 40 + j] * rs + brg[j];
            float gm = gl[0];
#pragma unroll
            for (int j = 1; j < 4; ++j) if (gl[j] > gm) { gm = gl[j]; grp = j; }
            float den = 0.f;
#pragma unroll
            for (int j = 0; j < 4; ++j) den += __expf(gl[j] - gm);
            const float pgrp = 1.f / den;
            float el[8];
#pragma unroll
            for (int j = 0; j < 8; ++j) el[j] = lg[tid * 40 + 4 + 8 * grp + j] * rs + bre[8 * grp + j];
            int i0 = 0; float v0 = el[0];
#pragma unroll
            for (int j = 1; j < 8; ++j) if (el[j] > v0) { v0 = el[j]; i0 = j; }
            int i1 = -1; float v1 = 0.f;
#pragma unroll
            for (int j = 0; j < 8; ++j) if (j != i0 && (i1 < 0 || el[j] > v1)) { v1 = el[j]; i1 = j; }
            const float ex = __expf(v1 - v0); const float w0 = 1.f / (1.f + ex);
            g0 = pgrp * w0; g1 = pgrp * (ex * w0);
            e0 = 8 * grp + i0; e1 = 8 * grp + i1;
            r0 = __hip_atomic_fetch_add(rc + e0, 1, __ATOMIC_RELAXED, __HIP_MEMORY_SCOPE_WORKGROUP);
            r1 = __hip_atomic_fetch_add(rc + e1, 1, __ATOMIC_RELAXED, __HIP_MEMORY_SCOPE_WORKGROUP);
        }
        __syncthreads();
        if (tid < 32) { const int c = rc[tid]; rb[tid] = c ? (int)__hip_atomic_fetch_add(cntg + tid, (unsigned)c, __ATOMIC_RELAXED, __HIP_MEMORY_SCOPE_AGENT) : 0; }
        __syncthreads();
        if (tid < 128) {
            r0 += rb[e0]; r1 += rb[e1];
            list[e0 * NTOK + r0] = row; glist[e0 * NTOK + r0] = g0; rslist[e0 * NTOK + r0] = rsv;
            list[e1 * NTOK + r1] = row; glist[e1 * NTOK + r1] = g1; rslist[e1 * NTOK + r1] = rsv;
            *(GAS i32x4*)(assign + row * 4) = (i32x4){e0, r0, e1, r1};
        }
        __syncthreads();
    }
}
struct EpiGU {
    const GAS float* rslist; GAS unsigned char* H;
    __device__ __forceinline__ void operator()(const f32x4 (&acc)[2][2][4][2], const GUnit& u, LAS unsigned char* lds, int wid, int lane) const {
        const int wr = wid >> 2, wc = wid & 3, fr = lane & 15, fq = lane >> 4;
        float rsv[2][4];
        const LAS float* rsl = (const LAS float*)(lds + LM_RS) + 256 * u.ord;
#pragma unroll
        for (int ai = 0; ai < 2; ++ai)
#pragma unroll
            for (int m = 0; m < 4; ++m) rsv[ai][m] = rsl[u.rbase + (ai < u.nai ? 128 * ai : 0) + 64 * wr + 16 * m + fr];
#pragma unroll
        for (int ai = 0; ai < 2; ++ai)
#pragma unroll
            for (int m = 0; m < 4; ++m) {
                if (ai >= u.nai) continue;
                const int rl = u.rbase + 128 * ai + 64 * wr + 16 * m + fr; const float rs = rsv[ai][m];
                f32x4 h[2];
#pragma unroll
                for (int n = 0; n < 2; ++n) { const f32x4 g = acc[ai][0][m][n] * rs, up = acc[ai][1][m][n] * rs;
#pragma unroll
                    for (int i = 0; i < 4; ++i) h[n][i] = g[i] * __builtin_amdgcn_rcpf(1.f + __expf(-g[i])) * up[i]; }
                int w0 = __builtin_amdgcn_cvt_pk_fp8_f32(h[0].x, h[0].y, 0, false); w0 = __builtin_amdgcn_cvt_pk_fp8_f32(h[0].z, h[0].w, w0, true);
                int w1 = __builtin_amdgcn_cvt_pk_fp8_f32(h[1].x, h[1].y, 0, false); w1 = __builtin_amdgcn_cvt_pk_fp8_f32(h[1].z, h[1].w, w1, true);
                *(GAS i32x2*)(H + (unsigned)((256 * u.T + rl) * DE + 128 * u.pn + 32 * wc + 8 * fq)) = (i32x2){w0, w1};
            }
    }
};
struct EpiDown {
    const GAS float* glist; GAS unsigned char* Y;
    __device__ __forceinline__ void operator()(const f32x4 (&acc)[2][2][4][2], const GUnit& u, LAS unsigned char* lds, int wid, int lane) const {
        const int wr = wid >> 2, wc = wid & 3, fr = lane & 15, fq = lane >> 4;
        float gtv[2][4];
        const LAS float* rsl = (const LAS float*)(lds + LM_RS) + 256 * u.ord;
#pragma unroll
        for (int ai = 0; ai < 2; ++ai)
#pragma unroll
            for (int m = 0; m < 4; ++m) gtv[ai][m] = rsl[u.rbase + (ai < u.nai ? 128 * ai : 0) + 64 * wr + 16 * m + fr];
#pragma unroll
        for (int ai = 0; ai < 2; ++ai)
#pragma unroll
            for (int m = 0; m < 4; ++m) {
                if (ai >= u.nai) continue;
                const int rl = u.rbase + 128 * ai + 64 * wr + 16 * m + fr; const float gt = gtv[ai][m];
#pragma unroll
                for (int bj = 0; bj < 2; ++bj) { const f32x4 y0 = acc[ai][bj][m][0] * (gt * 16.f), y1 = acc[ai][bj][m][1] * (gt * 16.f);
                    int w0 = __builtin_amdgcn_cvt_pk_fp8_f32(y0.x, y0.y, 0, false); w0 = __builtin_amdgcn_cvt_pk_fp8_f32(y0.z, y0.w, w0, true);
                    int w1 = __builtin_amdgcn_cvt_pk_fp8_f32(y1.x, y1.y, 0, false); w1 = __builtin_amdgcn_cvt_pk_fp8_f32(y1.z, y1.w, w1, true);
                    *(GAS i32x2*)(Y + (unsigned)((256 * u.T + rl) * DM + 256 * u.pn + 128 * bj + 32 * wc + 8 * fq)) = (i32x2){w0, w1}; }
            }
    }
};

template <int KS, int VS, class MaskF>
__device__ __forceinline__ void attn_tile32(const bf16x8 (&qf)[4], const LAS char* Kt, const LAS char* Vt, f32x16 (&o)[2], float& lsum, int lane, const MaskF& mf) {
    const int r32 = lane & 31, hi = lane >> 5;
    f32x16 s; float bb[16];
#pragma unroll
    for (int r = 0; r < 16; ++r) { s[r] = 0.f; bb[r] = mf.bias(r, crow(r, hi)); }
#pragma unroll
    for (int d0 = 0; d0 < 4; ++d0) { const bf16x8 kf = *(const LAS bf16x8*)(Kt + r32 * KS + (16 * d0 + 8 * hi) * 2); s = MFMA32(kf, qf[d0], s); }
    float ps = 0.f;
#pragma unroll
    for (int r = 0; r < 16; ++r) { const float p = __builtin_amdgcn_exp2f(s[r] + bb[r]); s[r] = p; ps += p; }
    lsum += ps;
    u32x4 pw0, pw1;
    pw0.x = pk2(s[0], s[1]); pw0.y = pk2(s[2], s[3]); pw0.z = pk2(s[4], s[5]); pw0.w = pk2(s[6], s[7]);
    pw1.x = pk2(s[8], s[9]); pw1.y = pk2(s[10], s[11]); pw1.z = pk2(s[12], s[13]); pw1.w = pk2(s[14], s[15]);
    const LAS char* vb = Vt + (4 * hi + ((lane & 15) >> 2)) * VS + ((lane >> 4) & 1) * 32 + (lane & 3) * 8;
    const int vsw = (((lane & 15) >> 3) & 1) * 64;
    const LAS char* vb0 = vb + vsw; const LAS char* vb1 = vb + (64 ^ vsw);
#pragma unroll
    for (int d0 = 0; d0 < 2; ++d0) {
#pragma unroll
        for (int st = 0; st < 2; ++st) {
            const LAS char* vbd = d0 ? vb1 : vb0; const s16x4 lo = vtr(vbd + (16 * st) * VS), h4 = vtr(vbd + (16 * st + 8) * VS);
            const bf16x8 vf = {lo[0], lo[1], lo[2], lo[3], h4[0], h4[1], h4[2], h4[3]};
            o[d0] = MFMA32(__builtin_bit_cast(bf16x8, st == 0 ? pw0 : pw1), vf, o[d0]);
        }
    }
}
#define SBAR() __builtin_amdgcn_sched_barrier(0)
template <bool HAS_NEXT, bool HAS_PRE, int KS, int VS, class MaskF>
__device__ __forceinline__ void attn_m_step(f32x16& Sc, f32x16& Sn, const bf16x8 (&qf)[4], bf16x8 (&kf)[4], const LAS char* Kpre, const LAS char* Vc, f32x16 (&o)[2], float& lsum, int lane, const MaskF& mfn, bool pre_rt = true) {
    const int r32 = lane & 31, hi = lane >> 5;
    s16x4 vlo[2][2], vhi[2][2];
    if (HAS_NEXT) { float bb[16]; mfn.fill(bb, hi);
#pragma unroll
        for (int r = 0; r < 16; ++r) Sn[r] = bb[r]; }
    const LAS char* vb = Vc + (4 * hi + ((lane & 15) >> 2)) * VS + ((lane >> 4) & 1) * 32 + (lane & 3) * 8;
    const int vsw = (((lane & 15) >> 3) & 1) * 64;
    const LAS char* vb0 = vb + vsw; const LAS char* vb1 = vb + (64 ^ vsw);
#pragma unroll
    for (int d0 = 0; d0 < 2; ++d0)
#pragma unroll
        for (int st = 0; st < 2; ++st) { const LAS char* vbd = d0 ? vb1 : vb0; vlo[d0][st] = vtr(vbd + (16 * st) * VS); vhi[d0][st] = vtr(vbd + (16 * st + 8) * VS); }
    SBAR();
    float ps = 0.f;
#pragma unroll
    for (int g = 0; g < 4; ++g) {
        if (HAS_NEXT) Sn = MFMA32(kf[g], qf[g], Sn);
#pragma unroll
        for (int i = 0; i < 4; ++i) { Sc[4 * g + i] = __builtin_amdgcn_exp2f(Sc[4 * g + i]); ps += Sc[4 * g + i]; }
        SBAR();
    }
    lsum += ps;
    if (HAS_PRE && pre_rt) {
#pragma unroll
        for (int d0 = 0; d0 < 4; ++d0) kf[d0] = *(const LAS bf16x8*)(Kpre + r32 * KS + (16 * d0 + 8 * hi) * 2);
    }
    u32x4 pw0, pw1;
    pw0.x = pk2(Sc[0], Sc[1]); pw0.y = pk2(Sc[2], Sc[3]); pw0.z = pk2(Sc[4], Sc[5]); pw0.w = pk2(Sc[6], Sc[7]);
    pw1.x = pk2(Sc[8], Sc[9]); pw1.y = pk2(Sc[10], Sc[11]); pw1.z = pk2(Sc[12], Sc[13]); pw1.w = pk2(Sc[14], Sc[15]);
#pragma unroll
    for (int d0 = 0; d0 < 2; ++d0)
#pragma unroll
        for (int st = 0; st < 2; ++st) {
            const bf16x8 vf = {vlo[d0][st][0], vlo[d0][st][1], vlo[d0][st][2], vlo[d0][st][3], vhi[d0][st][0], vhi[d0][st][1], vhi[d0][st][2], vhi[d0][st][3]};
            o[d0] = MFMA32(__builtin_bit_cast(bf16x8, st == 0 ? pw0 : pw1), vf, o[d0]);
        }
}
template <int KS, class MaskF>
__device__ __forceinline__ void attn_qk_head(f32x16& S, const bf16x8 (&qf)[4], const LAS char* Kt, int lane, const MaskF& mf) {
    const int r32 = lane & 31, hi = lane >> 5;
    { float bb[16]; mf.fill(bb, hi);
#pragma unroll
      for (int r = 0; r < 16; ++r) S[r] = bb[r]; }
#pragma unroll
    for (int d0 = 0; d0 < 4; ++d0) { const bf16x8 k0 = *(const LAS bf16x8*)(Kt + r32 * KS + (16 * d0 + 8 * hi) * 2); S = MFMA32(k0, qf[d0], S); }
}
template <int KS>
__device__ __forceinline__ void attn_kf_load(bf16x8 (&kf)[4], const LAS char* Kt, int lane) {
    const int r32 = lane & 31, hi = lane >> 5;
#pragma unroll
    for (int d0 = 0; d0 < 4; ++d0) kf[d0] = *(const LAS bf16x8*)(Kt + r32 * KS + (16 * d0 + 8 * hi) * 2);
}
struct TokLin { size_t base; __device__ __forceinline__ size_t operator()(int q) const { return base + q; } };
struct TokDil { size_t base; int dil; __device__ __forceinline__ size_t operator()(int q) const { return base + (size_t)dil * q; } };
template <class TokF>
__device__ __forceinline__ void store_o(const f32x16 (&o)[2], float sc, GAS bf16_t* dst, int ld, int lane, const TokF& tokf) {
    const int r32 = lane & 31, hi = lane >> 5;
#pragma unroll
    for (int r = 0; r < 16; ++r) { const int q = crow(r, hi); const float f = shl(sc, q); const size_t off = (size_t)tokf(q) * ld + r32;
        dst[off] = f2bf(o[0][r] * f); dst[off + 32] = f2bf(o[1][r] * f); }
}
__device__ __forceinline__ float gain_bound(const GAS float* g  , int lane) { return wave_max(fabsf(g[lane]), lane) * wave_max(fabsf(g[64 + lane]), lane); }

struct MaskA { const LAS float* tp; int vb;
    __device__ __forceinline__ float bias(int r, int) const { const int c = (r & 3) + 8 * (r >> 2); return ((unsigned)(vb + c) < 16u) ? tp[c] : -INFINITY; }
    __device__ __forceinline__ void fill(float (&bb)[16], int hi) const {
#pragma unroll
        for (int r = 0; r < 16; ++r) bb[r] = bias(r, 0); } };
__device__ __forceinline__ void p_attn_a(const GArgs& a, int l, LAS unsigned char* lds, int wv) {
    const int tid = otid(wv), lane = tid & 63, wave = rfl(tid >> 6);
    constexpr int KS = 144, VS = 128, L_K = 0, L_V = 512 * KS, L_OACC = L_V + 512 * VS  , L_LACC = L_OACC + 16384, L_TAB = L_LACC + 256;
    static_assert(L_TAB + 7440 <= L_BARW, "LDS map (attention A)");
    const GAS bf16_t* qkv = (const GAS bf16_t*)(a.ws + WS_QKV); GAS bf16_t* oA = (GAS bf16_t*)(a.ws + WS_OBUF + OB_A);
    const GAS float* rpb = a.in[I_RPB] + (size_t)l * 4 * 15 * 31;
    LAS float* tab = (LAS float*)(lds + L_TAB); LAS float* oacc = (LAS float*)(lds + L_OACC); LAS float* lacc = (LAS float*)(lds + L_LACC);
    const int r32 = lane & 31, hi = lane >> 5;
    __syncthreads();
    const float mref = ((const GAS float*)(a.ws + WS_RPBMAX))[4 * l + 0];
    for (int i = tid; i < 1860; i += NTHR) tab[i] = rpb[i] * LOG2E - mref;
    const int qh = wave & 1, kp = wave >> 1;
    const int qc = 32 * qh + r32; int cs = qc - 8; cs = cs < 0 ? 0 : (cs > 48 ? 48 : cs);
    for (int unit = xcd_vcu(); unit < BATCH * 4 * 8; unit += gridDim.x) {
        const int b = unit >> 5, h = (unit >> 3) & 3, rb = unit & 7;
        const size_t tokb = (size_t)b * SEQ;
        const int rfirst = 8 * rb; int r0 = rfirst - 4; r0 = r0 < 0 ? 0 : (r0 > 56 ? 56 : r0);
        lds_barrier();
        { u32x4 kv[8], vv[8];
#pragma unroll
          for (int i = 0; i < 8; ++i) { const int row = 64 * i + (tid >> 3), ch = tid & 7; const size_t tok = tokb + (size_t)(r0 + (row >> 6)) * 64 + (row & 63);
              kv[i] = *(const GAS u32x4*)(qkv + tok * INC + COL_KA + 64 * h + 8 * ch); vv[i] = *(const GAS u32x4*)(qkv + tok * INC + COL_VA + 64 * h + 8 * ch); }
          asm volatile("" : "+v"(kv[0]), "+v"(kv[1]), "+v"(kv[2]), "+v"(kv[3]), "+v"(kv[4]), "+v"(kv[5]), "+v"(kv[6]), "+v"(kv[7]));
          asm volatile("" : "+v"(vv[0]), "+v"(vv[1]), "+v"(vv[2]), "+v"(vv[3]), "+v"(vv[4]), "+v"(vv[5]), "+v"(vv[6]), "+v"(vv[7]));
#pragma unroll
          for (int i = 0; i < 8; ++i) { const int row = 64 * i + (tid >> 3), ch = tid & 7; const int kr = r0 + (row >> 6), slot = kr & 7, kc = row & 63;
              *(LAS u32x4*)(lds + L_K + (slot * 64 + kc) * KS + ch * 16) = kv[i]; *(LAS u32x4*)(lds + L_V + v_off(slot * 64 + kc, ch)) = vv[i]; } }
        bf16x8 qf[4];
#pragma unroll
        for (int d0 = 0; d0 < 4; ++d0) qf[d0] = *(const GAS bf16x8*)(qkv + (tokb + (size_t)rfirst * 64 + 32 * qh + r32) * INC + COL_QA + 64 * h + 16 * d0 + 8 * hi);
        asm volatile("" : "+v"(qf[0]), "+v"(qf[1]), "+v"(qf[2]), "+v"(qf[3]));
#pragma unroll 1
        for (int rr = 0; rr < 8; ++rr) {
            const int r = rfirst + rr;
            int r0n = r + 1 - 4; r0n = r0n < 0 ? 0 : (r0n > 56 ? 56 : r0n);
            const bool slide = (rr < 7) && (r0n > r0);
            lds_barrier();
            u32x4 nk = {0u, 0u, 0u, 0u}, nv = {0u, 0u, 0u, 0u}; bf16x8 qn[4];
            if (slide) { const size_t tok = tokb + (size_t)(r0n + 7) * 64 + (tid >> 3);
                nk = *(const GAS u32x4*)(qkv + tok * INC + COL_KA + 64 * h + 8 * (tid & 7)); nv = *(const GAS u32x4*)(qkv + tok * INC + COL_VA + 64 * h + 8 * (tid & 7)); }
            if (rr < 7) {
#pragma unroll
                for (int d0 = 0; d0 < 4; ++d0) qn[d0] = *(const GAS bf16x8*)(qkv + (tokb + (size_t)(r + 1) * 64 + 32 * qh + r32) * INC + COL_QA + 64 * h + 16 * d0 + 8 * hi);
            }
            f32x16 o[2]; float lsum = 0.f;
#pragma unroll
            for (int r_ = 0; r_ < 16; ++r_) { o[0][r_] = 0.f; o[1][r_] = 0.f; }
            { const int kr0 = r0 + 2 * kp, s0 = kr0 & 7, s1 = (kr0 + 1) & 7;
              const LAS char* K0 = (const LAS char*)(lds + L_K + (s0 * 64) * KS); const LAS char* K1 = (const LAS char*)(lds + L_K + (s1 * 64) * KS);
              const LAS char* V0 = (const LAS char*)(lds + L_V + (s0 * 64) * VS); const LAS char* V1 = (const LAS char*)(lds + L_V + (s1 * 64) * VS);
              const LAS float* t0 = tab + h * 465 + (kr0 - r + 7) * 31 + (4 * hi + 15 - qc); const LAS float* t1 = t0 + 31;
              f32x16 SA, SB; bf16x8 kf[4];
              { MaskA mf{t0, 4 * hi - cs};      attn_qk_head<KS>(SA, qf, K0, lane, mf); } attn_kf_load<KS>(kf, K0 + 32 * KS, lane);
              { MaskA mf{t0 + 32, 32 + 4 * hi - cs}; attn_m_step<true, true, KS, VS>(SA, SB, qf, kf, K1, V0, o, lsum, lane, mf); }
              { MaskA mf{t1, 4 * hi - cs};      attn_m_step<true, true, KS, VS>(SB, SA, qf, kf, K1 + 32 * KS, V0 + 32 * VS, o, lsum, lane, mf); }
              { MaskA mf{t1 + 32, 32 + 4 * hi - cs}; attn_m_step<true, false, KS, VS>(SA, SB, qf, kf, K1, V1, o, lsum, lane, mf); }
              { MaskA mf{t1 + 32, 32 + 4 * hi - cs}; attn_m_step<false, false, KS, VS>(SB, SA, qf, kf, K1, V1 + 32 * VS, o, lsum, lane, mf); } }
#pragma unroll 1
            for (int k = 0; k < 4; ++k) {
                if (kp == k) {
                    if (k == 0) {
#pragma unroll
                        for (int r_ = 0; r_ < 16; ++r_) { LAS float* p = oacc + (32 * qh + crow(r_, hi)) * 64 + r32; p[0] = o[0][r_]; p[32] = o[1][r_]; }
                        lsum += shx(lsum, 32, lane);
                        if (hi == 0) lacc[32 * qh + r32] = lsum;
                    } else {
                        float t0[16], t1[16];
#pragma unroll
                        for (int r_ = 0; r_ < 16; ++r_) { const LAS float* p = oacc + (32 * qh + crow(r_, hi)) * 64 + r32; t0[r_] = p[0]; t1[r_] = p[32]; }
                        const float lprev = lacc[32 * qh + r32];
                        lsum += shx(lsum, 32, lane);
                        asm volatile("s_waitcnt lgkmcnt(0)" ::: "memory");
#pragma unroll
                        for (int r_ = 0; r_ < 16; ++r_) { LAS float* p = oacc + (32 * qh + crow(r_, hi)) * 64 + r32; p[0] = t0[r_] + o[0][r_]; p[32] = t1[r_] + o[1][r_]; }
                        if (hi == 0) lacc[32 * qh + r32] = lprev + lsum;
                    }
                }
                lds_barrier();
            }
            asm volatile("" : "+v"(nk), "+v"(nv));
            if (rr < 7) asm volatile("" : "+v"(qn[0]), "+v"(qn[1]), "+v"(qn[2]), "+v"(qn[3]));
            { const int q = tid >> 3, d8 = (tid & 7) * 8; const LAS float* p = oacc + q * 64 + d8;
              const f32x4 v0 = *(const LAS f32x4*)p, v1 = *(const LAS f32x4*)(p + 4); const float inv = 1.f / lacc[q];
              u32x4 w; w.x = pk2(v0.x * inv, v0.y * inv); w.y = pk2(v0.z * inv, v0.w * inv); w.z = pk2(v1.x * inv, v1.y * inv); w.w = pk2(v1.z * inv, v1.w * inv);
              *(GAS u32x4*)(oA + (tokb + (size_t)r * 64 + q) * 256 + 64 * h + d8) = w; }
            if (slide) { const int slot = (r0n + 7) & 7, kc = tid >> 3;
                *(LAS u32x4*)(lds + L_K + (slot * 64 + kc) * KS + (tid & 7) * 16) = nk; *(LAS u32x4*)(lds + L_V + v_off(slot * 64 + kc, tid & 7)) = nv; }
            if (rr < 7) {
#pragma unroll
                for (int d0 = 0; d0 < 4; ++d0) qf[d0] = qn[d0];
            }
            r0 = r0n;
        }
    }
    lds_barrier();
}

struct MaskB { float dlf, slope2, mref; bool chk, rng; int ukey0, L;
    __device__ __forceinline__ float bias(int r, int key) const {
        const float x = dlf + (float)((r & 3) + 8 * (r >> 2)); float b = fmaf(-slope2, fabsf(x), -mref);
        if (chk) b = (fabsf(x) <= 64.f) ? b : -INFINITY;
        if (rng) b = ((unsigned)(ukey0 + key) < (unsigned)L) ? b : -INFINITY;
        return b; }
    __device__ __forceinline__ void fill(float (&bb)[16], int hi) const {
        float d = dlf; asm volatile("" : "+v"(d));
#pragma unroll
        for (int r = 0; r < 16; ++r) { const float x = d + (float)((r & 3) + 8 * (r >> 2)); bb[r] = fmaf(-slope2, fabsf(x), -mref); }
        if (chk) {
#pragma unroll
            for (int r = 0; r < 16; ++r) { const float x = d + (float)((r & 3) + 8 * (r >> 2)); bb[r] = (fabsf(x) <= 64.f) ? bb[r] : -INFINITY; } }
        if (rng) {
#pragma unroll
            for (int r = 0; r < 16; ++r) bb[r] = ((unsigned)(ukey0 + crow(r, hi)) < (unsigned)L) ? bb[r] : -INFINITY; }
    } };
struct BUnit { int h, br, dil, L, rho, u0; size_t tokb; };
__device__ __forceinline__ BUnit b_unit(int unit) {
    if (gridDim.x == 256) unit = 192 * ((unit & 255) >> 5) + (unit & 31) + 32 * (unit >> 8);
    BUnit u; const int b = unit / 192, rem = unit % 192, w48 = rem % 48, sub = w48 & 15; u.h = rem / 48; u.br = w48 >> 4;
    u.dil = (u.br == 0) ? 1 : (u.br == 1 ? 4 : 16); u.L = SEQ / u.dil; u.rho = sub % u.dil; u.u0 = 256 * (sub / u.dil); u.tokb = (size_t)b * SEQ; return u;
}
__device__ __forceinline__ void p_attn_b(const GArgs& a, int l, LAS unsigned char* lds, int wv) {
    const int tid = otid(wv), lane = tid & 63, wave = rfl(tid >> 6);
    constexpr int KS = 144, VS = 128, NK = 384, L_K = 0, L_V = NK * KS, L_STG = L_V + NK * VS, NU = BATCH * 4 * 48;
    const GAS bf16_t* qkv = (const GAS bf16_t*)(a.ws + WS_QKV); GAS bf16_t* oB = (GAS bf16_t*)(a.ws + WS_OBUF + OB_B); GAS float* lB = (GAS float*)(a.ws + WS_LB);
    const int r32 = lane & 31, hi = lane >> 5;
    const float mref = ((const GAS float*)(a.ws + WS_RPBMAX))[4 * l + 1];
    u32x4 kv[6], vv[6];
#define B_LOAD(U) do { _Pragma("unroll") for (int i = 0; i < 6; ++i) { const int idx = tid + NTHR * i, row = idx >> 3, ch = idx & 7; const int up = (U).u0 - 64 + row; const int upc = up < 0 ? 0 : (up >= (U).L ? (U).L - 1 : up); \
            const size_t tok = (U).tokb + (size_t)(U).dil * upc + (U).rho; kv[i] = *(const GAS u32x4*)(qkv + tok * INC + COL_KB + 64 * (U).h + 8 * ch); vv[i] = *(const GAS u32x4*)(qkv + tok * INC + COL_VB + 64 * (U).h + 8 * ch); } \
        } while (0)
    int unit = xcd_vcu();
    if (unit < NU) { const BUnit u = b_unit(unit); B_LOAD(u); }
#pragma unroll 1
    for (; unit < NU; unit += gridDim.x) {
        const BUnit u = b_unit(unit);
        const int dil = u.dil, L = u.L, rho = u.rho, u0 = u.u0, h = u.h, br = u.br; const size_t tokb = u.tokb;
        bf16x8 qf[4];
#pragma unroll
        for (int d0 = 0; d0 < 4; ++d0) qf[d0] = *(const GAS bf16x8*)(qkv + (tokb + (size_t)dil * (u0 + 32 * wave + r32) + rho) * INC + COL_QB + 64 * h + 16 * d0 + 8 * hi);
        lds_barrier();
#pragma unroll
        for (int i = 0; i < 6; ++i) { const int idx = tid + NTHR * i, row = idx >> 3, ch = idx & 7; const int up = u0 - 64 + row; const bool ok = (up >= 0) && (up < L);
            const u32x4 z = {0u, 0u, 0u, 0u};
            *(LAS u32x4*)(lds + L_K + row * KS + ch * 16) = ok ? kv[i] : z; *(LAS u32x4*)(lds + L_V + v_off(row, ch)) = ok ? vv[i] : z; }
        asm volatile("" : "+v"(qf[0]), "+v"(qf[1]), "+v"(qf[2]), "+v"(qf[3]));
        lds_barrier();
        if (unit + (int)gridDim.x < NU) { const BUnit un = b_unit(unit + (int)gridDim.x); B_LOAD(un); }
        const int uq = u0 + 32 * wave;
        f32x16 o[2]; float lsum = 0.f;
#pragma unroll
        for (int r_ = 0; r_ < 16; ++r_) { o[0][r_] = 0.f; o[1][r_] = 0.f; }
        const float slope2 = exp2f(-2.f * (float)(h + 1)) * (float)dil * LOG2E;
        { const LAS char* Kw = (const LAS char*)(lds + L_K + 32 * wave * KS); const LAS char* Vw = (const LAS char*)(lds + L_V + 32 * wave * VS);
          const float dl0 = (float)(4 * hi - r32 - 64); const int uk = uq - 64;
          f32x16 SA, SB; bf16x8 kf[4];
          attn_kf_load<KS>(kf, Kw + 32 * KS, lane);
#define MB(j, chk) MaskB{dl0 + 32.f * (float)(j), slope2, mref, chk, (uk + 32 * (j) < 0) || (uk + 32 * (j) + 31 >= L), uk + 32 * (j), L}
          { MaskB mf = MB(0, true); attn_qk_head<KS>(SA, qf, Kw, lane, mf); }
#pragma unroll 1
          for (int jj = 0; jj < 4; jj += 2) {
              { MaskB mf = MB(jj + 1, false);    attn_m_step<true, true, KS, VS>(SA, SB, qf, kf, Kw + (jj + 2) * 32 * KS, Vw + jj * 32 * VS, o, lsum, lane, mf); }
              { MaskB mf = MB(jj + 2, jj == 2);  attn_m_step<true, true, KS, VS>(SB, SA, qf, kf, Kw + (jj + 3) * 32 * KS, Vw + (jj + 1) * 32 * VS, o, lsum, lane, mf, jj == 0); }
          }
          { MaskB mf = MB(4, true);  attn_m_step<false, false, KS, VS>(SA, SB, qf, kf, Kw, Vw + 128 * VS, o, lsum, lane, mf); }
#undef MB
        }
        lsum += shx(lsum, 32, lane);
        {
          LAS bf16_t* stg = (LAS bf16_t*)(lds + L_STG + wave * 4096);
#pragma unroll
          for (int r_ = 0; r_ < 16; ++r_) { const int q = crow(r_, hi); stg[q * 64 + r32] = f2bf(o[0][r_]); stg[q * 64 + 32 + r32] = f2bf(o[1][r_]); }
          asm volatile("s_waitcnt lgkmcnt(0)" ::: "memory");
          GAS bf16_t* ob = oB + (size_t)br * NTOK * 256 + 64 * h;
#pragma unroll
          for (int j = 0; j < 4; ++j) { const int c = lane + 64 * j, q = c >> 3, d8 = (c & 7) * 8; const u32x4 v = *(const LAS u32x4*)(stg + q * 64 + d8);
              *(GAS u32x4*)(ob + (tokb + (size_t)dil * (uq + q) + rho) * 256 + d8) = v; } }
        if (hi == 0) lB[(tokb + (size_t)dil * (uq + r32) + rho) * 16 + 4 * h + br] = lsum;
    }
#undef B_LOAD
}

#define MFMA8S(a_, b_, c_) __builtin_amdgcn_mfma_scale_f32_32x32x64_f8f6f4(a_, b_, c_, 0, 0, 0, 0x82828282, 0, 0x7F7F7F7F)
#define MFMA8(a_, b_, c_) __builtin_amdgcn_mfma_scale_f32_32x32x64_f8f6f4(a_, b_, c_, 0, 0, 0, 0x7F7F7F7F, 0, 0x7F7F7F7F)
constexpr int KS8 = 80;
__device__ __forceinline__ i32x8 kf8_load(const LAS char* Kt, int lane) {
    const int r32 = lane & 31, hi = lane >> 5;
    const i32x4 lo = *(const LAS i32x4*)(Kt + r32 * KS8 + 32 * hi), h4 = *(const LAS i32x4*)(Kt + r32 * KS8 + 32 * hi + 16);
    return (i32x8){lo.x, lo.y, lo.z, lo.w, h4.x, h4.y, h4.z, h4.w};
}
constexpr int VS8 = 144;
__device__ __forceinline__ i32x8 vf8_load(const LAS char* Vt, int lane) {
    const int r32 = lane & 31, hi = lane >> 5;
    const i32x4 lo = *(const LAS i32x4*)(Vt + r32 * VS8 + 32 * hi), h4 = *(const LAS i32x4*)(Vt + r32 * VS8 + 32 * hi + 16);
    return (i32x8){lo.x, lo.y, lo.z, lo.w, h4.x, h4.y, h4.z, h4.w};
}
__device__ __forceinline__ void attn_c_pack(const f32x16& Sc, int& p0, int& p1, int& p2, int& p3) {
#define PK8(g_) __builtin_amdgcn_cvt_pk_u8_f32(Sc[4 * (g_) + 3], 3, __builtin_amdgcn_cvt_pk_u8_f32(Sc[4 * (g_) + 2], 2, __builtin_amdgcn_cvt_pk_u8_f32(Sc[4 * (g_) + 1], 1, __builtin_amdgcn_cvt_pk_u8_f32(Sc[4 * (g_)], 0, 0u))))
    p0 = (int)PK8(0); p1 = (int)PK8(1); p2 = (int)PK8(2); p3 = (int)PK8(3);
#undef PK8
}
template <bool NEXT>
__device__ __forceinline__ void attn_c_pair(f32x16& SA, f32x16& SB, const i32x8& qf, i32x8& kf, const LAS char* K2, const LAS char* K3, const LAS char* Vg, f32x16 (&o)[2], f32x4& lacc, const f32x16& negv, const i32x8& ones, int lane) {
    const i32x8 v0 = vf8_load(Vg, lane), v1 = vf8_load(Vg + 32 * VS8, lane);
    SBAR();
    SB = MFMA8S(kf, qf, negv);
    int p0, p1, p2, p3, p4, p5, p6, p7;
    attn_c_pack(SA, p0, p1, p2, p3);
    if (NEXT) kf = kf8_load(K2, lane);
    SBAR();
    if (NEXT) SA = MFMA8S(kf, qf, negv);
    attn_c_pack(SB, p4, p5, p6, p7);
    if (NEXT) kf = kf8_load(K3, lane);
    SBAR();
    const i32x8 pw = {p0, p1, p2, p3, p4, p5, p6, p7};
    o[0] = MFMA8(pw, v0, o[0]); o[1] = MFMA8(pw, v1, o[1]);
    lacc = __builtin_amdgcn_mfma_scale_f32_16x16x128_f8f6f4(pw, ones, lacc, 0, 0, 0, 0x7F7F7F7F, 0, 0x7F7F7F7F);
}
__device__ __forceinline__ void p_attn_c(const GArgs& a, int l, LAS unsigned char* lds, int wv) {
    const int tid = otid(wv), lane = tid & 63, wave = rfl(tid >> 6);
    constexpr int TK = 128, KB = TK * KS8, VB = 64 * VS8, L_K = 0, L_V = 3 * KB, L_STG = L_V + 3 * VB, NT = SEQ / TK, ROWB = INC * 2, QC8 = COL_QC * 2;
    static_assert(L_STG + 8 * 4096 <= L_BARW, "LDS map (attention C)");
    const GAS unsigned char* qkv8 = (const GAS unsigned char*)(a.ws + WS_QKV); const GAS unsigned char* vt8 = (const GAS unsigned char*)(a.ws + WS_VT8);
    const int r32 = lane & 31, hi = lane >> 5;
    const float negm = -8.f * ((const GAS float*)(a.ws + WS_RPBMAX))[4 * l + 2] + 56.5f;
    f32x16 negv;
#pragma unroll
    for (int r_ = 0; r_ < 16; ++r_) negv[r_] = negm;
    i32x8 ones;
    { const int sv = ((((lane & 15) < 8) ? 1 : 0) ^ ((lane >> 4) & 1)) ? 0x38383838 : 0;
#pragma unroll
      for (int r_ = 0; r_ < 8; ++r_) ones[r_] = sv; }
    if (wave >= 4) __builtin_amdgcn_s_setprio(1);
    for (int unit = xcd_vcu(); unit < BATCH * 2 * 64; unit += gridDim.x) {
        const int b = unit >> 7, kvh = (unit >> 6) & 1, qb = unit & 63;
        const int head = 4 * kvh + (wave >> 1);
        const size_t tokb = (size_t)b * SEQ, tokq = tokb + 64 * qb + 32 * (wave & 1);
        i32x8 qf;
        { const GAS unsigned char* qp = qkv8 + (tokq + r32) * ROWB + QC8 + 64 * head + 32 * hi; const i32x4 lo = *(const GAS i32x4*)qp, h4 = *(const GAS i32x4*)(qp + 16);
          qf = (i32x8){lo.x, lo.y, lo.z, lo.w, h4.x, h4.y, h4.z, h4.w}; }
        const GAS unsigned char* ksrc = qkv8 + (tokb + (tid >> 2)) * ROWB + QC8 + 512 + 64 * kvh + 16 * (tid & 3);
        const GAS unsigned char* vsrc = vt8 + (size_t)((b * 2 + kvh) * 64 + (tid >> 3)) * SEQ + 16 * (tid & 7);
        const int kdst = L_K + (tid >> 2) * KS8 + (tid & 3) * 16, vdst = L_V + (tid >> 3) * VS8 + (tid & 7) * 16;
        u32x4 rk, rv;
        lds_barrier();
#pragma unroll
        for (int tt = 0; tt < 2; ++tt) {
            rk = *(const GAS u32x4*)(ksrc + (size_t)(tt * TK) * ROWB); rv = *(const GAS u32x4*)(vsrc + tt * TK);
            *(LAS u32x4*)(lds + kdst + tt * KB) = rk; *(LAS u32x4*)(lds + vdst + tt * VB) = rv;
        }
        lds_barrier();
        f32x16 o[2]; f32x4 l2 = {0.f, 0.f, 0.f, 0.f};
#pragma unroll
        for (int r_ = 0; r_ < 16; ++r_) { o[0][r_] = 0.f; o[1][r_] = 0.f; }
        f32x16 SA, SB; i32x8 kf;
        { const i32x8 k0 = kf8_load((const LAS char*)(lds + L_K), lane); SA = MFMA8S(k0, qf, negv); }
        kf = kf8_load((const LAS char*)(lds + L_K + 32 * KS8), lane);
        int sc = 0, sn = 1, sw = 2;
        for (int t = 0; t < NT - 1; ++t) {
            if (t + 2 < NT) { rk = *(const GAS u32x4*)(ksrc + (size_t)((t + 2) * TK) * ROWB); rv = *(const GAS u32x4*)(vsrc + (t + 2) * TK); }
            { const LAS char* Kc = (const LAS char*)(lds + L_K + sc * KB); const LAS char* Kn = (const LAS char*)(lds + L_K + sn * KB); const LAS char* Vc = (const LAS char*)(lds + L_V + sc * VB);
              attn_c_pair<true>(SA, SB, qf, kf, Kc + 64 * KS8, Kc + 96 * KS8, Vc, o, l2, negv, ones, lane);
              attn_c_pair<true>(SA, SB, qf, kf, Kn, Kn + 32 * KS8, Vc + 64, o, l2, negv, ones, lane); }
            if (t + 2 < NT) { *(LAS u32x4*)(lds + kdst + sw * KB) = rk; *(LAS u32x4*)(lds + vdst + sw * VB) = rv; }
            lds_barrier();
            const int tmp = sc; sc = sn; sn = sw; sw = tmp;
        }
        { const LAS char* Kc = (const LAS char*)(lds + L_K + sc * KB); const LAS char* Vc = (const LAS char*)(lds + L_V + sc * VB);
          attn_c_pair<true>(SA, SB, qf, kf, Kc + 64 * KS8, Kc + 96 * KS8, Vc, o, l2, negv, ones, lane);
          attn_c_pair<false>(SA, SB, qf, kf, Kc, Kc, Vc + 64, o, l2, negv, ones, lane); }
        {
          LAS bf16_t* stg = (LAS bf16_t*)(lds + L_STG + wave * 4096);
          GAS bf16_t* oCe = (GAS bf16_t*)(oq(a.ws) + WS_OBUF + OB_C);
          { LAS float* lsum = (LAS float*)stg;
            if ((lane & 7) == 0) { const int qb_ = 2 * (lane & 8) + 4 * (lane >> 4);
#pragma unroll
                for (int i = 0; i < 4; ++i) lsum[qb_ + i] = l2[i]; }
            asm volatile("s_waitcnt lgkmcnt(0)" ::: "memory"); }
          float fl[16];
#pragma unroll
          for (int r_ = 0; r_ < 16; ++r_) fl[r_] = ((const LAS float*)stg)[crow(r_, hi)];
          asm volatile("s_waitcnt lgkmcnt(0)" ::: "memory");
#pragma unroll
          for (int r_ = 0; r_ < 16; ++r_) { const int q = crow(r_, hi); const float f = __builtin_amdgcn_rcpf(fl[r_]); stg[q * 64 + r32] = f2bf(o[0][r_] * f); stg[q * 64 + 32 + r32] = f2bf(o[1][r_] * f); }
          asm volatile("s_waitcnt lgkmcnt(0)" ::: "memory");
#pragma unroll
          for (int j = 0; j < 4; ++j) { const int c = lane + 64 * j, q = c >> 3, d8 = (c & 7) * 8; const u32x4 v = *(const LAS u32x4*)(stg + q * 64 + d8);
              *(GAS u32x4*)(oCe + (tokq + q) * 512 + 64 * head + d8) = v; } }
    }
    __builtin_amdgcn_s_setprio(0);
}

__device__ __forceinline__ void p_mixnorm(const GArgs& a, int wv) {
    const int tid_ = otid(wv), lane = tid_ & 63, wave = rfl(tid_ >> 6);
    const GAS bf16_t* oA = (const GAS bf16_t*)(a.ws + WS_OBUF + OB_A); const GAS bf16_t* oC = (const GAS bf16_t*)(a.ws + WS_OBUF + OB_C); const GAS bf16_t* oB = (const GAS bf16_t*)(a.ws + WS_OBUF + OB_B);
    const GAS float* lB = (const GAS float*)(a.ws + WS_LB); GAS bf16_t* mb = (GAS bf16_t*)(a.ws + WS_MB);
    const int gw = blockIdx.x * NWAVES + wave, NGW = gridDim.x * NWAVES;
    constexpr int RB = 4;
    for (int row0 = gw * RB; row0 < NTOK; row0 += NGW * RB) {
        u32x2 wa[RB], wb[RB][3], wc[RB][2]; f32x4 lv[RB];
#pragma unroll
        for (int q = 0; q < RB; ++q) { const size_t row = row0 + q;
            wa[q] = *(const GAS u32x2*)(oA + row * 256 + 4 * lane);
#pragma unroll
            for (int br = 0; br < 3; ++br) wb[q][br] = *(const GAS u32x2*)(oB + ((size_t)br * NTOK + row) * 256 + 4 * lane);
            lv[q] = *(const GAS f32x4*)(lB + row * 16 + 4 * (lane >> 4));
#pragma unroll
            for (int j = 0; j < 2; ++j) wc[q][j] = *(const GAS u32x2*)(oC + row * 512 + 4 * lane + 256 * j); }
#pragma unroll
        for (int q = 0; q < RB; ++q) { const size_t row = row0 + q;
            f32x4 v[4];
            v[0] = (f32x4){bflo(wa[q].x), bfhi(wa[q].x), bflo(wa[q].y), bfhi(wa[q].y)};
            { f32x4 s = {0.f, 0.f, 0.f, 0.f};
#pragma unroll
              for (int br = 0; br < 3; ++br) s += (f32x4){bflo(wb[q][br].x), bfhi(wb[q][br].x), bflo(wb[q][br].y), bfhi(wb[q][br].y)};
              v[1] = s * (1.f / (lv[q].x + lv[q].y + lv[q].z)); }
#pragma unroll
            for (int j = 0; j < 2; ++j) v[2 + j] = (f32x4){bflo(wc[q][j].x), bfhi(wc[q][j].x), bflo(wc[q][j].y), bfhi(wc[q][j].y)};
            float sa = (v[0].x * v[0].x + v[0].y * v[0].y) + (v[0].z * v[0].z + v[0].w * v[0].w);
            float sb = (v[1].x * v[1].x + v[1].y * v[1].y) + (v[1].z * v[1].z + v[1].w * v[1].w);
            float sc = (v[2].x * v[2].x + v[2].y * v[2].y) + (v[2].z * v[2].z + v[2].w * v[2].w) + (v[3].x * v[3].x + v[3].y * v[3].y) + (v[3].z * v[3].z + v[3].w * v[3].w);
            sa = wave_sum(sa, lane); sb = wave_sum(sb, lane); sc = wave_sum(sc, lane);
            const float ra = 1.f / sqrtf(sa * (1.f / 256.f) + RMS_EPS), rb = 1.f / sqrtf(sb * (1.f / 256.f) + RMS_EPS), rc = 1.f / sqrtf(sc * (1.f / 512.f) + RMS_EPS);
            v[0] = v[0] * ra; v[1] = v[1] * rb; v[2] = v[2] * rc; v[3] = v[3] * rc;
#pragma unroll
            for (int j = 0; j < 4; ++j) { u32x2 o; o.x = pk2(v[j].x, v[j].y); o.y = pk2(v[j].z, v[j].w); *(GAS u32x2*)(mb + row * DM + 4 * lane + 256 * j) = o; } }
    }
}

constexpr int PPL = 10, N_PHASES = 2 + PPL * DEPTH;
__global__ void __launch_bounds__(NTHR, 2) fwd(Args a_unused) {
    extern __shared__ __attribute__((aligned(16))) unsigned char lds_raw[];
    LAS unsigned char* lds = (LAS unsigned char*)lds_raw;
    const int wv = rfl((int)threadIdx.x >> 6);
    const int tid = otid(wv);
    int lo, hi; unsigned* barw; { const GArgs a0 = kargs(); barw = (unsigned*)((GAS unsigned*)(a0.ws + WS_CTL) + CW_BAR + a0.li * XCD_BAR_WORDS); lo = a0.ph_lo; hi = a0.ph_hi; }
    if (tid < 16) ((LAS unsigned*)(lds + L_BARW))[tid] = 0u;
    __syncthreads();
    XcdBarrier bar; bar.bar = barw; bar.x = 0; bar.st = nullptr;
    if (hi - lo > 1) bar = xcd_barrier_post(barw, (volatile LAS unsigned*)(lds + L_BARW), tid == 0);
#ifdef PH_ONLY
#define PHSEL(j) ((j) == PH_ONLY)
#else
#define PHSEL(j) true
#endif
#define IN(p) (lo <= (p) && (p) < hi)
#define SEAM(p) do { if ((p) + 1 < hi) xcd_barrier(bar, otid(wv) == 0); } while (0)
#define SOFT(p) do { if ((p) + 1 < hi) __syncthreads(); } while (0)
#define PHASE_ENV const GArgs a = kargs(); GAS unsigned char* ws = a.ws; GAS unsigned* ctl = (GAS unsigned*)(ws + WS_CTL); GAS bf16_t* xb = (GAS bf16_t*)(ws + WS_XB); GAS bf16_t* mbuf = (GAS bf16_t*)(ws + WS_MB); GAS bf16_t* qkv = (GAS bf16_t*)(ws + WS_QKV); (void)ctl; (void)xb; (void)mbuf; (void)qkv

    if (PHSEL(100) && IN(0)) { { PHASE_ENV; p0_prologue(a, lds, wv); } SOFT(0); }
    for (int l = 0; l < DEPTH; ++l) {
        const int pb = 1 + PPL * l;
        if (PHSEL(0) && IN(pb + 0)) { { PHASE_ENV; p_combine(a, l, false, lds, wv); } SEAM(pb + 0); }
        if (PHSEL(1) && IN(pb + 1)) {
            { PHASE_ENV;
            FDense S{xb, (const GAS bf16_t*)(ws + WS_WIN) + (size_t)l * INC * DM, DM, NTOK / 256, INC / 256};
            EpiQKV E{(const GAS float*)(ws + WS_RSTD1), a.in[I_QKG] + (size_t)l * 384, (const GAS f32x2*)(ws + WS_ROPE), qkv, (GAS unsigned char*)(ws + WS_VT8)};
            { const int t_ = otid(wv); const f32x2 r0_ = E.rope[t_], r1_ = E.rope[t_ + NTHR]; LAS f32x2* rl_ = (LAS f32x2*)(lds + L_MISC); rl_[t_] = r0_; rl_[t_ + NTHR] = r1_; }
            gemm_fast<false>(lds, S, E, DM, wv); }
            SEAM(pb + 1);
        }
        if (PHSEL(2) && IN(pb + 2)) { { PHASE_ENV; p_attn_a(a, l, lds, wv); } SOFT(pb + 2); }
        if (PHSEL(3) && IN(pb + 3)) { { PHASE_ENV; p_attn_b(a, l, lds, wv); } SOFT(pb + 3); }
        if (PHSEL(4) && IN(pb + 4)) { { PHASE_ENV; p_attn_c(a, l, lds, wv); } SEAM(pb + 4); }
        if (PHSEL(5) && IN(pb + 5)) { { PHASE_ENV; p_mixnorm(a, wv); } SEAM(pb + 5); }
        if (PHSEL(6) && IN(pb + 6)) {
            { PHASE_ENV;
            FDense S{mbuf, (const GAS bf16_t*)(ws + WS_WOUT) + (size_t)l * DM * DM, DM, NTOK / 256, DM / 256};
            EpiWout E{xb, (GAS float*)(ws + WS_SSQP), (GAS unsigned char*)(ws + WS_X8)};
            gemm_fast<false>(lds, S, E, DM, wv); }
            SEAM(pb + 6);
        }
        if (PHSEL(7) && IN(pb + 7)) { { PHASE_ENV; p_router(a, l, lds, wv); } SEAM(pb + 7); }
        if (PHSEL(8) && IN(pb + 8)) {
            { PHASE_ENV;
            moe_tables(ctl, l, lds, wv);
            FMoe S{(const GAS bf16_t*)(ws + WS_X8), (const GAS bf16_t*)((const GAS unsigned char*)(ws + WS_WGU) + (size_t)l * NE * DM * DM), (size_t)DM * DM / 2, DM / 2, true};
            moe_units((const GAS int*)(ws + WS_LIST), true, (const GAS float*)(ws + WS_RSLIST), lds, wv);
            EpiGU E{(const GAS float*)(ws + WS_RSLIST), (GAS unsigned char*)(ws + WS_OBUF)};
            gemm_fast<true>(lds, S, E, DM / 2, wv); }
            SEAM(pb + 8);
        }
        if (PHSEL(9) && IN(pb + 9)) {
            { PHASE_ENV;
            moe_tables(ctl, l, lds, wv);
            FMoe S{(const GAS bf16_t*)(ws + WS_OBUF), (const GAS bf16_t*)((const GAS unsigned char*)(ws + WS_WD) + (size_t)l * NE * DM * DE), (size_t)DM * DE / 2, DE / 2, false};
            moe_units((const GAS int*)(ws + WS_LIST), false, (const GAS float*)(ws + WS_GLIST), lds, wv);
            EpiDown E{(const GAS float*)(ws + WS_GLIST), (GAS unsigned char*)qkv};
            gemm_fast<true>(lds, S, E, DE / 2, wv); }
            SEAM(pb + 9);
        }
    }
    if (PHSEL(101) && IN(N_PHASES - 1)) { PHASE_ENV; p_combine(a, DEPTH, true, lds, wv); }
#undef IN
#undef SEAM
#undef SOFT
}

extern "C" void kernel_launch(void* const* d_in, const int* in_sizes, int n_in, void* d_out, int out_size, void* d_ws, size_t ws_size, hipStream_t stream) {
    static int grid = 0;
    if (grid == 0) {
        if (n_in != 15 || in_sizes[0] != NTOK * DM || out_size != NTOK * DM || ws_size < WS_END) { fprintf(stderr, "kernel_launch: unexpected shapes (n_in %d, in0 %d, out %d, ws %zu)\n", n_in, n_in > 0 ? in_sizes[0] : -1, out_size, ws_size); grid = -1; return; }
        int dev = 0, cus = 0;
        if (hipGetDevice(&dev) != hipSuccess || hipDeviceGetAttribute(&cus, hipDeviceAttributeMultiprocessorCount, dev) != hipSuccess) { grid = -1; return; }
        if (hipFuncSetAttribute((const void*)fwd, hipFuncAttributeMaxDynamicSharedMemorySize, LDS_BYTES) != hipSuccess) { fprintf(stderr, "kernel_launch: hipFuncSetAttribute failed\n"); grid = -1; return; }
        int per_cu = 0;
        if (hipOccupancyMaxActiveBlocksPerMultiprocessor(&per_cu, (const void*)fwd, NTHR, LDS_BYTES) != hipSuccess || per_cu < 1) fprintf(stderr, "kernel_launch: occupancy query reports %d\n", per_cu);
        (void)hipGetLastError();
        grid = cus;
    }
    if (grid < 0) return;
    (void)hipMemsetAsync((char*)d_ws + WS_CTL, 0, CTL_ZERO_BYTES, stream);
    Args a{};
    for (int i = 0; i < 15; ++i) a.in[i] = (const float*)d_in[i];
    a.out = (float*)d_out; a.ws = (unsigned char*)d_ws;
    int li = 0;
    auto launch = [&](int lo, int hi) { a.ph_lo = lo; a.ph_hi = hi; a.li = li++; hipLaunchKernelGGL(fwd, dim3(grid), dim3(NTHR), LDS_BYTES, stream, a); };
#if PROBE_PHASE >= 0
    { int start = 0;
      for (int l = 0; l < DEPTH; ++l) { const int p = 1 + PPL * l + PROBE_PHASE; launch(start, p + 1); launch(p, p + 1); start = p + 1; }
      launch(start, N_PHASES); }
#elif MK_ONE_LAUNCH
    launch(0, N_PHASES);
#else
    for (int p = 0; p < N_PHASES; ++p) launch(p, p + 1);
#endif
}
```
